# Optimizing an MI355X kernel written in HIP

```python
import jax, jax.numpy as jnp
from jax import lax
import numpy as np

D_MODEL = 1024
BATCH = 16
SEQ = 4096
DEPTH = 2

CHUNK = 64
SGU_BLOCK = 128
SGU_HEADS = 4
SGU_DIM = D_MODEL // 2
SGU_HEAD_DIM = SGU_DIM // SGU_HEADS
POOL_WINDOWS = (2, 4, 8, 16)
POOL_GROUPS = len(POOL_WINDOWS)
POOL_DIM = D_MODEL // 2
POOL_GROUP_DIM = POOL_DIM // POOL_GROUPS
IN_AB = 2 * SGU_DIM + POOL_DIM
MIX_AB = SGU_DIM + POOL_DIM
CONV_WIDTH = 3
CONV_DIM = D_MODEL
D_FF = ((-(-8 * D_MODEL // 3) + 255) // 256) * 256
N_EVEN = (DEPTH + 1) // 2
N_ODD = DEPTH // 2
EPS = 1e-6

kernel_name = "hybrid_sgu_pool_shortconv_trunk"


def rms_norm(x, g):
    xf = x.astype(jnp.float32)
    y = xf * lax.rsqrt(jnp.mean(xf * xf, axis=-1, keepdims=True) + EPS)
    return (y * g.astype(jnp.float32)).astype(x.dtype)


def layer_norm(x, g, b):
    xf = x.astype(jnp.float32)
    mu = jnp.mean(xf, axis=-1, keepdims=True)
    xc = xf - mu
    var = jnp.mean(xc * xc, axis=-1, keepdims=True)
    y = xc * lax.rsqrt(var + EPS)
    return (y * g.astype(jnp.float32) + b.astype(jnp.float32)).astype(x.dtype)


def sgu_mixer(z, ln_g, ln_b, ws, bs):
    bsz, s, _ = z.shape
    u = z[..., :SGU_DIM]
    v = layer_norm(z[..., SGU_DIM:], ln_g, ln_b)
    v = v.reshape(bsz, s // SGU_BLOCK, SGU_BLOCK, SGU_HEADS, SGU_HEAD_DIM)
    chunk_id = jnp.arange(SGU_BLOCK) // CHUNK
    mask = chunk_id[None, :] <= chunk_id[:, None]
    w = jnp.where(mask[None], ws, jnp.zeros_like(ws))
    vs = jnp.einsum('hij,bnjhd->bnihd', w, v) + bs[None, None, :, :, None]
    return u * vs.reshape(bsz, s, SGU_DIM)


def pool_mixer(p, pool_w, pool_b, pool_scale):
    s = p.shape[1]
    pf = p.astype(jnp.float32)
    cs = jnp.cumsum(pf, axis=1)
    t = jnp.arange(s)
    outs = []
    for g, win in enumerate(POOL_WINDOWS):
        sl = slice(g * POOL_GROUP_DIM, (g + 1) * POOL_GROUP_DIM)
        c = cs[..., sl]
        c_prev = jnp.pad(c[:, :-win], ((0, 0), (win, 0), (0, 0)))
        count = jnp.minimum(t + 1, win).astype(jnp.float32)[None, :, None]
        d = ((c - c_prev) / count - pf[..., sl]).astype(p.dtype)
        outs.append(d @ pool_w[g] + pool_b[g])
    return jnp.concatenate(outs, axis=-1) * pool_scale


def short_conv_mixer(h, conv_w, conv_b):
    s = h.shape[1]
    b_gate = h[..., :CONV_DIM]
    c_gate = h[..., CONV_DIM:2 * CONV_DIM]
    hv = h[..., 2 * CONV_DIM:]
    q = c_gate * hv
    qp = jnp.pad(q, ((0, 0), (CONV_WIDTH - 1, 0), (0, 0)))
    y = conv_b + sum(conv_w[k] * qp[:, k:k + s] for k in range(CONV_WIDTH))
    return b_gate * y


def swiglu(x, w_gate, w_up, w_down):
    return (jax.nn.silu(x @ w_gate) * (x @ w_up)) @ w_down


def setup_inputs(seed: int = 0) -> dict:
    key = jax.random.key(seed)
    ks = jax.random.split(key, 32)
    f32 = jnp.float32

    def nrm(k, shape, fan_in):
        return jax.random.normal(k, shape, f32) * (fan_in ** -0.5)

    def gain(k, shape):
        return 1.0 + 0.05 * jax.random.normal(k, shape, f32)

    def small(k, shape):
        return 0.02 * jax.random.normal(k, shape, f32)

    return {
        "x": jax.random.normal(ks[0], (BATCH, SEQ, D_MODEL), f32),
        "even_norm": gain(ks[1], (N_EVEN, D_MODEL)),
        "even_w_in": nrm(ks[2], (N_EVEN, D_MODEL, IN_AB), D_MODEL),
        "even_sgu_ln_g": gain(ks[3], (N_EVEN, SGU_DIM)),
        "even_sgu_ln_b": small(ks[4], (N_EVEN, SGU_DIM)),
        "even_sgu_ws": nrm(ks[5], (N_EVEN, SGU_HEADS, SGU_BLOCK, SGU_BLOCK), SGU_BLOCK),
        "even_sgu_bs": 1.0 + 0.1 * jax.random.normal(ks[6], (N_EVEN, SGU_BLOCK, SGU_HEADS), f32),
        "even_pool_w": nrm(ks[7], (N_EVEN, POOL_GROUPS, POOL_GROUP_DIM, POOL_GROUP_DIM), POOL_GROUP_DIM),
        "even_pool_b": small(ks[8], (N_EVEN, POOL_GROUPS, POOL_GROUP_DIM)),
        "even_pool_scale": gain(ks[9], (N_EVEN, POOL_DIM)),
        "even_w_out": nrm(ks[10], (N_EVEN, MIX_AB, D_MODEL), MIX_AB),
        "odd_norm": gain(ks[11], (N_ODD, D_MODEL)),
        "odd_w_in": nrm(ks[12], (N_ODD, D_MODEL, 3 * CONV_DIM), D_MODEL),
        "odd_conv_w": nrm(ks[13], (N_ODD, CONV_WIDTH, CONV_DIM), CONV_WIDTH),
        "odd_conv_b": small(ks[14], (N_ODD, CONV_DIM)),
        "odd_w_out": nrm(ks[15], (N_ODD, CONV_DIM, D_MODEL), CONV_DIM),
        "ffn_norm": gain(ks[16], (DEPTH, D_MODEL)),
        "ffn_w_gate": nrm(ks[17], (DEPTH, D_MODEL, D_FF), D_MODEL),
        "ffn_w_up": nrm(ks[18], (DEPTH, D_MODEL, D_FF), D_MODEL),
        "ffn_w_down": nrm(ks[19], (DEPTH, D_FF, D_MODEL), D_FF),
        "final_norm": gain(ks[20], (D_MODEL,)),
    }


def reference(x, even_norm, even_w_in, even_sgu_ln_g, even_sgu_ln_b, even_sgu_ws,
              even_sgu_bs, even_pool_w, even_pool_b, even_pool_scale, even_w_out,
              odd_norm, odd_w_in, odd_conv_w, odd_conv_b, odd_w_out,
              ffn_norm, ffn_w_gate, ffn_w_up, ffn_w_down, final_norm):
    for layer in range(DEPTH):
        i = layer // 2
        if layer % 2 == 0:
            hn = rms_norm(x, even_norm[i])
            h = hn @ even_w_in[i]
            z = jax.nn.gelu(h[..., :2 * SGU_DIM], approximate=False)
            a_out = sgu_mixer(z, even_sgu_ln_g[i], even_sgu_ln_b[i],
                              even_sgu_ws[i], even_sgu_bs[i])
            b_out = pool_mixer(h[..., 2 * SGU_DIM:], even_pool_w[i],
                               even_pool_b[i], even_pool_scale[i])
            mix = jnp.concatenate([a_out, b_out], axis=-1) @ even_w_out[i]
        else:
            hn = rms_norm(x, odd_norm[i])
            h = hn @ odd_w_in[i]
            mix = short_conv_mixer(h, odd_conv_w[i], odd_conv_b[i]) @ odd_w_out[i]
        x = x + mix
        hn = rms_norm(x, ffn_norm[layer])
        x = x + swiglu(hn, ffn_w_gate[layer], ffn_w_up[layer], ffn_w_down[layer])
    return rms_norm(x, final_norm)
```

```cpp
#include <hip/hip_runtime.h>
#include <hip/hip_cooperative_groups.h>
#include <cstdio>
#include <cstdint>
namespace cg = cooperative_groups;
#ifndef DUP
#define DUP 0
#endif
#ifndef KL_SP2
#define KL_SP2 1
#endif
#ifndef KL_PRIO
#define KL_PRIO 1
#endif
#ifndef KL_ALIGN
#define KL_ALIGN 1
#endif

#define LAS __attribute__((address_space(3)))
typedef unsigned short bf16;
typedef short bf16x8 __attribute__((ext_vector_type(8)));
typedef float f32x4 __attribute__((ext_vector_type(4)));
typedef float f32x2 __attribute__((ext_vector_type(2)));
typedef unsigned u32x4 __attribute__((ext_vector_type(4)));
typedef unsigned u32x2 __attribute__((ext_vector_type(2)));

constexpr int M = 65536, D = 1024, FF = 2816, SEQ = 4096;
constexpr int N_IN0 = 1536, N_IN1 = 3072, N_GU = 2 * FF;
constexpr float EPS = 1e-6f;

constexpr size_t MiB = 1u << 20;
constexpr size_t WS_W1 = 0, WS_W2 = 3 * MiB, WS_W3 = 5 * MiB, WS_W4 = 16 * MiB, WS_W5 = 22 * MiB, WS_W6 = 28 * MiB, WS_W7 = 30 * MiB, WS_W8 = 41 * MiB;
constexpr size_t WS_WSM = 47 * MiB, WS_PWT = 47 * MiB + 128 * 1024;
constexpr size_t WS_CTL = 47 * MiB + 512 * 1024;
constexpr size_t WS_SS = 48 * MiB, SS_BYTES = 4 * MiB;
constexpr size_t WS_XBA = 68 * MiB, WS_XBB = 196 * MiB;
constexpr size_t WS_A = 324 * MiB;
constexpr size_t WS_H0 = WS_A, WS_MIX = WS_A + 192 * MiB, WS_ACT = WS_A, WS_Q1 = WS_A, WS_BG = WS_A + 128 * MiB, WS_CV = WS_A + 256 * MiB;
constexpr size_t WS_END = 708 * MiB;

constexpr int LDS_BYTES = 147456 + 256;
constexpr int MISC_OFF = 147456;

__device__ __forceinline__ unsigned cvt_pk_bf16(float lo, float hi) { unsigned r; asm volatile("v_cvt_pk_bf16_f32 %0, %1, %2" : "=v"(r) : "v"(lo), "v"(hi)); return r; }
__device__ __forceinline__ float bf_lo(unsigned w) { return __uint_as_float(w << 16); }
__device__ __forceinline__ float bf_hi(unsigned w) { return __uint_as_float(w & 0xffff0000u); }
__device__ __forceinline__ float wave_sum(float v) {
#pragma unroll
    for (int o = 1; o < 64; o <<= 1) v += __shfl_xor(v, o);
    return v;
}
__device__ __forceinline__ f32x2 gelu_pk(f32x2 v) {
    const f32x2 w = __builtin_elementwise_abs(v), x = w * 0.70710678118f;
    f32x2 p = x * 0.0000430638f + 0.0002765672f; p = p * x + 0.0001520143f; p = p * x + 0.0092705272f; p = p * x + 0.0422820123f; p = p * x + 0.0705230784f; p = p * x + 1.0f;
    f32x2 d = p * p; d = d * d; d = d * d; d = d * d;
    f32x2 q; q.x = __builtin_amdgcn_rcpf(d.x); q.y = __builtin_amdgcn_rcpf(d.y);
    const f32x2 t = w - w * q;
    return (v + t) * 0.5f;
}
__device__ __forceinline__ float silu_mul(float g, float u) { return g * __builtin_amdgcn_rcpf(1.0f + __builtin_amdgcn_exp2f(g * -1.44269504089f)) * u; }


#define XB_TMO      128
#define XB_XCNT(j)  (256  + 64 * (j))
#define XB_XSUB(j)  (1280 + 64 * (j))
#define XB_XGEN(j)  (2304 + 64 * (j))
#define XB_TOP      3328
#define XB_TOPGEN   3392
#define XCD_BAR_WORDS 3456
#define XB_SPIN_CAP (1u << 20)
__device__ __forceinline__ unsigned xb_ld(unsigned* p)              { return __hip_atomic_load(p, __ATOMIC_RELAXED, __HIP_MEMORY_SCOPE_AGENT); }
__device__ __forceinline__ unsigned xb_add(unsigned* p, unsigned v) { return __hip_atomic_fetch_add(p, v, __ATOMIC_RELAXED, __HIP_MEMORY_SCOPE_AGENT); }
__device__ __forceinline__ unsigned xb_xcc_id() { return (unsigned)__builtin_amdgcn_s_getreg((3 << 11) | 20) & 0xFu; }
#define XB_SPIN(cond, bar) do { unsigned _sp = 0; while (cond) { __builtin_amdgcn_s_sleep(1); \
    if ((++_sp & 255u) == 0u) { if (xb_ld(&(bar)[XB_TMO])) break; if (_sp > XB_SPIN_CAP) { atomicAdd(&(bar)[XB_TMO], 1u); break; } } } } while (0)
struct XcdBarrier { unsigned* bar; unsigned x; volatile LAS unsigned* st; };
__device__ __forceinline__ XcdBarrier xcd_barrier_post(unsigned* bar, volatile LAS unsigned* st) {
    XcdBarrier b; b.bar = bar; b.x = xb_xcc_id(); b.st = st;
    if (threadIdx.x == 0) (void)xb_add(&bar[XB_XCNT(b.x)], 1u);
    return b;
}
__device__ __forceinline__ void xcd_barrier_complete(unsigned* bar, unsigned x, unsigned& nloc, unsigned& nx) {
    const unsigned G = gridDim.x * gridDim.y * gridDim.z;
    unsigned sum, cnt, mine, sp = 0u;
    for (;;) {
        sum = 0u; cnt = 0u; mine = 0u;
#pragma unroll
        for (unsigned j = 0; j < 16; ++j) { const unsigned c = xb_ld(&bar[XB_XCNT(j)]); sum += c; cnt += (c > 0u) ? 1u : 0u; mine = (j == x) ? c : mine; }
        if (sum == G) break;
        __builtin_amdgcn_s_sleep(1);
        if ((++sp & 255u) == 0u) { if (xb_ld(&bar[XB_TMO])) break; if (sp > XB_SPIN_CAP) { atomicAdd(&bar[XB_TMO], 1u); break; } }
    }
    nloc = mine > 0u ? mine : 1u; nx = cnt > 0u ? cnt : 1u;
}
__device__ __forceinline__ void xcd_barrier(const XcdBarrier& b) {
    asm volatile("s_waitcnt vmcnt(0)" ::: "memory");
    __syncthreads();
    if (threadIdx.x == 0) {
        unsigned* bar = b.bar;
        __builtin_amdgcn_s_waitcnt(0);
        unsigned nloc = b.st[0], nx = b.st[1];
        if (nloc == 0u) { xcd_barrier_complete(bar, b.x, nloc, nx); b.st[0] = nloc; b.st[1] = nx; }
        const unsigned old = xb_add(&bar[XB_XSUB(b.x)], 1u);
        const unsigned gen = old / nloc;
        if (old + 1u == (gen + 1u) * nloc) {
            __builtin_amdgcn_fence(__ATOMIC_RELEASE, "agent");
            asm volatile("s_waitcnt vmcnt(0)" ::: "memory");
            const unsigned og = xb_add(&bar[XB_TOP], 1u);
            const unsigned tg = og / nx;
            if (og + 1u == (tg + 1u) * nx) xb_add(&bar[XB_TOPGEN], 1u);
            else XB_SPIN(xb_ld(&bar[XB_TOPGEN]) == tg, bar);
            __builtin_amdgcn_fence(__ATOMIC_ACQUIRE, "agent");
            xb_add(&bar[XB_XGEN(b.x)], 1u);
            asm volatile("s_waitcnt vmcnt(0)" ::: "memory");
        } else {
            XB_SPIN(xb_ld(&bar[XB_XGEN(b.x)]) == gen, bar);
            __builtin_amdgcn_fence(__ATOMIC_ACQUIRE, "agent");
            asm volatile("s_waitcnt vmcnt(0)" ::: "memory");
        }
    }
    __syncthreads();
}

namespace pg8 {
constexpr int BM = 256, BK = 64, HALF = 128, HTB = HALF * BK * 2, STAGE_BYTES = 8 * HTB, NXCD = 8, WGM = 8;
__host__ __device__ __forceinline__ int lds_byte(int r, int c) { const int st = (r >> 4) * 2 + (c >> 5), rr = r & 15, cc = c & 31, ob = rr * 64 + cc * 2; return st * 1024 + (ob ^ (((ob >> 9) & 1) << 5)); }
__host__ __device__ __forceinline__ void stage_rc(int b, int& R, int& C) { const int st = b / 1024, sb = b % 1024, swz = sb ^ (((sb >> 9) & 1) << 5); R = (st >> 1) * 16 + swz / 64; C = (st & 1) * 32 + (swz % 64) / 2; }
__host__ __device__ __forceinline__ int perm32(int rho) { const int n = rho >> 4, i = rho & 15; return 8 * (i >> 2) + 4 * n + (i & 3); }

struct Unit { int pm, pn; };
struct Gemm { const bf16* A; const bf16* Bt; int M, N, K; };

struct StaticOrder {
    int nM, nN, nwg, G, c; int fixed = 0; int rev = 0;
    __host__ __device__ void init(int M_, int N_, int G_, int c_) { nM = M_ / BM; nN = N_ / BM; nwg = nM * nN; G = G_; c = c_; }
    __host__ __device__ bool next(int i, Unit& u) const {
        if (rev && nwg % G == 0) { const int nr = nwg / G; if (i >= nr) return false; i = nr - 1 - i; }
        const long L = (long)i * G + c; if (L >= nwg) return false;
        int wgid = (int)L; { const int q = nwg / NXCD, r = nwg % NXCD, xcd = wgid % NXCD, off = wgid / NXCD; wgid = (xcd < r ? xcd * (q + 1) : r * (q + 1) + (xcd - r) * q) + off; }
        const int nig = WGM * nN, gid = wgid / nig, fm = gid * WGM, gsz = (nM - fm) < WGM ? (nM - fm) : WGM;
        u.pm = fm + ((wgid % nig) % gsz); u.pn = (wgid % nig) / gsz; if (fixed) { u.pm = c & 7; u.pn = 0; } return true;
    }
};

constexpr int RS_OFF = 131072;
__device__ __forceinline__ void prep_rstd(const float* SS, int pm, LAS float* rsl, int tid) {
    asm volatile("" : "+v"(tid));
    const int row = tid >> 1, hf = tid & 1;
    const f32x4* p = (const f32x4*)(SS + (size_t)(pm * BM + row) * 16 + hf * 8);
    const f32x4 s4 = p[0] + p[1]; float s = (s4.x + s4.y) + (s4.z + s4.w); s += __shfl_xor(s, 1);
    if (hf == 0) rsl[row] = __builtin_amdgcn_rsqf(s * (1.0f / 1024.0f) + EPS);
}
__device__ __forceinline__ void load_rstd(const LAS float* rsl, int rloc, float (&rs)[4]) {
#pragma unroll
    for (int m = 0; m < 4; ++m) rs[m] = rsl[rloc + m * 16];
}
struct EpiNormAct {
    static constexpr bool PERM = true, NEEDS_RS = true;
    bf16* O; int ldc; const float* SS; int gelu_tiles;
    __device__ __forceinline__ void operator()(const f32x4 (&acc)[2][2][4][2], const Unit& u, int wr, int wc, int fr, int fq, const LAS float* rsl) const {
        const int row0 = u.pm * BM + wr * 64 + fr, col0 = u.pn * BM + wc * 32 + 8 * fq;
        const bool act = u.pn < gelu_tiles;
#pragma unroll
        for (int ai = 0; ai < 2; ++ai) { float rs[4]; load_rstd(rsl, ai * HALF + wr * 64 + fr, rs);
#pragma unroll
            for (int m = 0; m < 4; ++m) { bf16* rowp = O + (size_t)(row0 + ai * HALF + m * 16) * ldc + col0; const float r = rs[m];
#pragma unroll
                for (int bj = 0; bj < 2; ++bj) { f32x4 v0 = acc[ai][bj][m][0] * r, v1 = acc[ai][bj][m][1] * r;
                    if (act) { f32x2 a = gelu_pk((f32x2){v0[0], v0[1]}), b = gelu_pk((f32x2){v0[2], v0[3]}), c = gelu_pk((f32x2){v1[0], v1[1]}), d = gelu_pk((f32x2){v1[2], v1[3]});
                        v0 = (f32x4){a.x, a.y, b.x, b.y}; v1 = (f32x4){c.x, c.y, d.x, d.y}; }
                    u32x4 w; w.x = cvt_pk_bf16(v0[0], v0[1]); w.y = cvt_pk_bf16(v0[2], v0[3]); w.z = cvt_pk_bf16(v1[0], v1[1]); w.w = cvt_pk_bf16(v1[2], v1[3]);
                    *(u32x4*)(rowp + bj * HALF) = w; }
                asm volatile("" ::: "memory"); } }
    }
};
struct EpiRes {
    static constexpr bool PERM = true, NEEDS_RS = false;
    const bf16* base; bf16* out; float* SS;
    __device__ __forceinline__ void operator()(const f32x4 (&acc)[2][2][4][2], const Unit& u, int wr, int wc, int fr, int fq, const LAS float* rsl) const {
        const int row0 = u.pm * BM + wr * 64 + fr, col0 = u.pn * BM + wc * 32 + 8 * fq;
#pragma unroll
        for (int ai = 0; ai < 2; ++ai) {
            u32x4 b[4][2];
#pragma unroll
            for (int m = 0; m < 4; ++m)
#pragma unroll
                for (int bj = 0; bj < 2; ++bj) b[m][bj] = *(const u32x4*)(base + (size_t)(row0 + ai * HALF + m * 16) * D + col0 + bj * HALF);
#pragma unroll
            for (int m = 0; m < 4; ++m) { const int row = row0 + ai * HALF + m * 16; const size_t off = (size_t)row * D + col0; float ssq = 0.f;
#pragma unroll
                for (int bj = 0; bj < 2; ++bj) { const u32x4 bb = b[m][bj];
                    const f32x4 o0 = acc[ai][bj][m][0] + (f32x4){bf_lo(bb.x), bf_hi(bb.x), bf_lo(bb.y), bf_hi(bb.y)}, o1 = acc[ai][bj][m][1] + (f32x4){bf_lo(bb.z), bf_hi(bb.z), bf_lo(bb.w), bf_hi(bb.w)};
                    ssq += ((o0[0] * o0[0] + o0[1] * o0[1]) + (o0[2] * o0[2] + o0[3] * o0[3])) + ((o1[0] * o1[0] + o1[1] * o1[1]) + (o1[2] * o1[2] + o1[3] * o1[3]));
                    u32x4 w; w.x = cvt_pk_bf16(o0[0], o0[1]); w.y = cvt_pk_bf16(o0[2], o0[3]); w.z = cvt_pk_bf16(o1[0], o1[1]); w.w = cvt_pk_bf16(o1[2], o1[3]);
                    *(u32x4*)(out + off + bj * HALF) = w; }
                ssq += __shfl_xor(ssq, 16); ssq += __shfl_xor(ssq, 32);
                if (fq == 0) SS[(size_t)row * 16 + u.pn * 4 + wc] = ssq; }
            asm volatile("" ::: "memory"); }
    }
};
struct EpiSwiglu {
    static constexpr bool PERM = true, NEEDS_RS = true;
    bf16* O; const float* SS;
    __device__ __forceinline__ f32x4 sw(const f32x4 g, const f32x4 u, float rl, float r2) const {
        const f32x4 t = g * rl; f32x4 d;
        d[0] = __builtin_amdgcn_exp2f(t[0]); d[1] = __builtin_amdgcn_exp2f(t[1]); d[2] = __builtin_amdgcn_exp2f(t[2]); d[3] = __builtin_amdgcn_exp2f(t[3]);
        d = d + 1.0f;
        f32x4 s; s[0] = __builtin_amdgcn_rcpf(d[0]); s[1] = __builtin_amdgcn_rcpf(d[1]); s[2] = __builtin_amdgcn_rcpf(d[2]); s[3] = __builtin_amdgcn_rcpf(d[3]);
        return (g * u) * r2 * s;
    }
    __device__ __forceinline__ void operator()(const f32x4 (&acc)[2][2][4][2], const Unit& u, int wr, int wc, int fr, int fq, const LAS float* rsl) const {
        const int row0 = u.pm * BM + wr * 64 + fr, col0 = u.pn * HALF + wc * 32 + 8 * fq;
#pragma unroll
        for (int ai = 0; ai < 2; ++ai) { float rs[4]; load_rstd(rsl, ai * HALF + wr * 64 + fr, rs);
#pragma unroll
            for (int m = 0; m < 4; ++m) { const float r = rs[m], rl = r * -1.44269504089f, r2 = r * r;
                const f32x4 o0 = sw(acc[ai][0][m][0], acc[ai][1][m][0], rl, r2), o1 = sw(acc[ai][0][m][1], acc[ai][1][m][1], rl, r2);
                u32x4 w; w.x = cvt_pk_bf16(o0[0], o0[1]); w.y = cvt_pk_bf16(o0[2], o0[3]); w.z = cvt_pk_bf16(o1[0], o1[1]); w.w = cvt_pk_bf16(o1[2], o1[3]);
                *(u32x4*)(O + (size_t)(row0 + ai * HALF + m * 16) * FF + col0) = w; asm volatile("" ::: "memory"); } }
    }
};
struct EpiNull { static constexpr bool PERM = true, NEEDS_RS = false; float* sink;
    __device__ __forceinline__ void operator()(const f32x4 (&acc)[2][2][4][2], const Unit& u, int wr, int wc, int fr, int fq, const LAS float* rsl) const {
        float s = 0.f;
#pragma unroll
        for (int ai = 0; ai < 2; ++ai)
#pragma unroll
            for (int m = 0; m < 4; ++m)
#pragma unroll
                for (int bj = 0; bj < 2; ++bj)
#pragma unroll
                    for (int n = 0; n < 2; ++n) s += acc[ai][bj][m][n][0] + acc[ai][bj][m][n][1] + acc[ai][bj][m][n][2] + acc[ai][bj][m][n][3];
        if (s == 123.456f) sink[0] = s; } };
struct EpiQ {
    static constexpr bool PERM = true, NEEDS_RS = true;
    bf16* Q1; const float* SS;
    __device__ __forceinline__ void operator()(const f32x4 (&acc)[2][2][4][2], const Unit& u, int wr, int wc, int fr, int fq, const LAS float* rsl) const {
        const int row0 = u.pm * BM + wr * 64 + fr;
        bf16* dst = Q1 + u.pn * HALF + wc * 32 + 8 * fq;
#pragma unroll
        for (int ai = 0; ai < 2; ++ai) { float rs[4]; load_rstd(rsl, ai * HALF + wr * 64 + fr, rs);
#pragma unroll
            for (int m = 0; m < 4; ++m) { const float r2 = rs[m] * rs[m];
                const f32x4 v0 = acc[ai][0][m][0] * acc[ai][1][m][0] * r2, v1 = acc[ai][0][m][1] * acc[ai][1][m][1] * r2;
                u32x4 w; w.x = cvt_pk_bf16(v0[0], v0[1]); w.y = cvt_pk_bf16(v0[2], v0[3]); w.z = cvt_pk_bf16(v1[0], v1[1]); w.w = cvt_pk_bf16(v1[2], v1[3]);
                *(u32x4*)(dst + (size_t)(row0 + ai * HALF + m * 16) * D) = w; }
            asm volatile("" ::: "memory"); }
    }
};
struct EpiConvGate {
    static constexpr bool PERM = true, NEEDS_RS = true;
    const bf16* Q1; bf16* CV; const float* SS; const float* cw; const float* cb;
    __device__ __forceinline__ void operator()(const f32x4 (&acc)[2][2][4][2], const Unit& u, int wr, int wc, int fr, int fq, const LAS float* rsl) const {
        int fq_ = fq, fr_ = fr; asm volatile("" : "+v"(fq_), "+v"(fr_));
        const int rloc0 = wr * 64 + fr_, row0 = u.pm * BM + rloc0;
        const u32x4 zero4 = (u32x4){0u, 0u, 0u, 0u};
#pragma unroll
        for (int bj = 0; bj < 2; ++bj) {
            const int c = u.pn * BM + bj * HALF + wc * 32 + 8 * fq_;
            const f32x4 w0a = *(const f32x4*)(cw + c), w0b = *(const f32x4*)(cw + c + 4), w1a = *(const f32x4*)(cw + D + c), w1b = *(const f32x4*)(cw + D + c + 4);
            const f32x4 w2a = *(const f32x4*)(cw + 2 * D + c), w2b = *(const f32x4*)(cw + 2 * D + c + 4), cba = *(const f32x4*)(cb + c), cbb = *(const f32x4*)(cb + c + 4);
#pragma unroll
            for (int ai = 0; ai < 2; ++ai) { float rs[4]; load_rstd(rsl, ai * HALF + rloc0, rs);
#pragma unroll
                for (int mp = 0; mp < 2; ++mp) {
                    u32x4 q[2][3];
#pragma unroll
                    for (int mm = 0; mm < 2; ++mm) { const int row = row0 + ai * HALF + (mp * 2 + mm) * 16, t = row & (SEQ - 1);
                        const bf16* p = Q1 + (size_t)row * D + c;
                        q[mm][0] = *(const u32x4*)p; q[mm][1] = *(const u32x4*)(t >= 1 ? p - D : p); q[mm][2] = *(const u32x4*)(t >= 2 ? p - 2 * D : p);
                        if (t < 1) q[mm][1] = zero4; if (t < 2) q[mm][2] = zero4; }
#pragma unroll
                    for (int mm = 0; mm < 2; ++mm) { const int m = mp * 2 + mm; const int row = row0 + ai * HALF + m * 16; const float r = rs[m];
                        const u32x4 a0 = q[mm][0], a1 = q[mm][1], a2 = q[mm][2];
                        const f32x4 ya = cba + w0a * (f32x4){bf_lo(a2.x), bf_hi(a2.x), bf_lo(a2.y), bf_hi(a2.y)} + w1a * (f32x4){bf_lo(a1.x), bf_hi(a1.x), bf_lo(a1.y), bf_hi(a1.y)} + w2a * (f32x4){bf_lo(a0.x), bf_hi(a0.x), bf_lo(a0.y), bf_hi(a0.y)};
                        const f32x4 yb = cbb + w0b * (f32x4){bf_lo(a2.z), bf_hi(a2.z), bf_lo(a2.w), bf_hi(a2.w)} + w1b * (f32x4){bf_lo(a1.z), bf_hi(a1.z), bf_lo(a1.w), bf_hi(a1.w)} + w2b * (f32x4){bf_lo(a0.z), bf_hi(a0.z), bf_lo(a0.w), bf_hi(a0.w)};
                        const f32x4 v0 = acc[ai][bj][m][0] * r * ya, v1 = acc[ai][bj][m][1] * r * yb;
                        u32x4 w; w.x = cvt_pk_bf16(v0[0], v0[1]); w.y = cvt_pk_bf16(v0[2], v0[3]); w.z = cvt_pk_bf16(v1[0], v1[1]); w.w = cvt_pk_bf16(v1[2], v1[3]);
                        *(u32x4*)(CV + (size_t)row * D + c) = w; }
                    asm volatile("" ::: "memory"); } }
        }
    }
};

template <class Epi, int PROBE = 0>
__device__ __forceinline__ void gemm_phase(LAS unsigned char* lds, const Gemm g, const StaticOrder& S, const Epi& E) {
    int tid_ = threadIdx.x; asm volatile("" : "+v"(tid_));
    const int tid = tid_, wid = __builtin_amdgcn_readfirstlane(tid >> 6), lane = tid & 63, wr = wid >> 2, wc = wid & 3, fr = lane & 15, fq = lane >> 4;
    const int K = g.K, nt = K / BK;
    unsigned voffA[2], voffB[2];
#pragma unroll
    for (int i = 0; i < 2; ++i) { int R, C; stage_rc(tid * 16 + i * 8192, R, C); const int Rb = Epi::PERM ? ((R & ~31) + perm32(R & 31)) : R;
        voffA[i] = (unsigned)(R * K + C) * 2u; voffB[i] = (unsigned)(Rb * K + C) * 2u; }
    const __amdgpu_buffer_rsrc_t rsA = __builtin_amdgcn_make_buffer_rsrc((void*)g.A, (short)0, (int)((size_t)g.M * K * 2), 0x00020000);
    const __amdgpu_buffer_rsrc_t rsB = __builtin_amdgcn_make_buffer_rsrc((void*)g.Bt, (short)0, (int)((size_t)g.N * K * 2), 0x00020000);
    const unsigned kstep = (unsigned)(BK * 2);
    const unsigned hstep = (unsigned)HALF * K * 2;
    const unsigned tstep = 2 * hstep;
    const unsigned ldsw = (unsigned)wid * 1024u;
    const int aoff = lds_byte(wr * 64 + fr, fq * 8), boff = lds_byte(wc * 32 + fr, fq * 8);
#define PG8_SA(b, h) (((b) * 2 + (h)) * HTB)
#define PG8_SB(b, h) ((4 + (b) * 2 + (h)) * HTB)
#define PG8_RS_voffA rsA
#define PG8_RS_voffB rsB
#define PG8_STAGE(bufoff, goff, voff) do { if (PROBE != 2) _Pragma("unroll") for (int _i = 0; _i < 2; ++_i) \
        __builtin_amdgcn_raw_ptr_buffer_load_lds(PG8_RS_##voff, (LAS void*)(lds + (bufoff) + ldsw + _i * 8192), 16, (int)(voff)[_i], (int)(goff), 0, 0); } while (0)
#define PG8_LDA(dst, b, h) do { _Pragma("unroll") for (int m = 0; m < 4; ++m) _Pragma("unroll") for (int k = 0; k < 2; ++k) dst[m][k] = *(const LAS bf16x8*)(lds + PG8_SA(b, h) + aoff + m * 2048 + k * 1024); } while (0)
#define PG8_LDB(dst, b, h) do { _Pragma("unroll") for (int n = 0; n < 2; ++n) _Pragma("unroll") for (int k = 0; k < 2; ++k) dst[n][k] = *(const LAS bf16x8*)(lds + PG8_SB(b, h) + boff + n * 2048 + k * 1024); } while (0)
#define PG8_MMA(ai, bj, At, Bt) do { if (KL_PRIO) __builtin_amdgcn_s_setprio(KL_PRIO); _Pragma("unroll") for (int m = 0; m < 4; ++m) _Pragma("unroll") for (int n = 0; n < 2; ++n) _Pragma("unroll") for (int k = 0; k < 2; ++k) { \
        if (PROBE == 1) asm volatile("" :: "v"(Bt[n][k]), "v"(At[m][k])); else acc[ai][bj][m][n] = __builtin_amdgcn_mfma_f32_16x16x32_bf16(Bt[n][k], At[m][k], acc[ai][bj][m][n], 0, 0, 0); } if (KL_PRIO) __builtin_amdgcn_s_setprio(0); } while (0)
#define PG8_MMAZ(ai, bj, At, Bt) do { if (KL_PRIO) __builtin_amdgcn_s_setprio(KL_PRIO); _Pragma("unroll") for (int m = 0; m < 4; ++m) _Pragma("unroll") for (int n = 0; n < 2; ++n) { \
        acc[ai][bj][m][n] = __builtin_amdgcn_mfma_f32_16x16x32_bf16(Bt[n][0], At[m][0], (f32x4){0.f, 0.f, 0.f, 0.f}, 0, 0, 0); \
        acc[ai][bj][m][n] = __builtin_amdgcn_mfma_f32_16x16x32_bf16(Bt[n][1], At[m][1], acc[ai][bj][m][n], 0, 0, 0); } if (KL_PRIO) __builtin_amdgcn_s_setprio(0); } while (0)
#define PG8_WAIT_V(n) asm volatile("s_waitcnt vmcnt(" #n ")" ::: "memory")
#define PG8_WAIT_L(n) asm volatile("s_waitcnt lgkmcnt(" #n ")" ::: "memory")
#define PG8_BAR __builtin_amdgcn_s_barrier()
#define PG8_SCHED __builtin_amdgcn_sched_barrier(0)
    Unit cur, nxt; int ui = 0;
    if (!S.next(0, cur)) return;
    f32x4 acc[2][2][4][2];
    bf16x8 At[4][2], B0[2][2], B1[2][2];
    unsigned cA = (unsigned)cur.pm * tstep, cB = (unsigned)cur.pn * tstep, ks = kstep;
    int slot = 0;
    if constexpr (Epi::NEEDS_RS) prep_rstd(E.SS, cur.pm, (LAS float*)(lds + RS_OFF), tid);
#if KL_SP2
    PG8_STAGE(PG8_SB(0, 0), cB, voffB); PG8_STAGE(PG8_SB(0, 1), cB + hstep, voffB); PG8_STAGE(PG8_SA(0, 0), cA, voffA); PG8_STAGE(PG8_SA(0, 1), cA + hstep, voffA);
    if (wr == 1) PG8_BAR;
    PG8_WAIT_V(2); PG8_BAR;
    PG8_STAGE(PG8_SB(1, 0), cB + ks, voffB); PG8_STAGE(PG8_SA(1, 0), cA + ks, voffA); PG8_STAGE(PG8_SB(1, 1), cB + hstep + ks, voffB);
    PG8_WAIT_V(6); PG8_BAR;
#else
    PG8_STAGE(PG8_SB(0, 0), cB, voffB); PG8_STAGE(PG8_SA(0, 0), cA, voffA); PG8_STAGE(PG8_SB(0, 1), cB + hstep, voffB); PG8_STAGE(PG8_SA(0, 1), cA + hstep, voffA);
    if (wr == 1) PG8_BAR;
    PG8_WAIT_V(4); PG8_BAR;
    PG8_STAGE(PG8_SB(1, 0), cB + ks, voffB); PG8_STAGE(PG8_SA(1, 0), cA + ks, voffA); PG8_STAGE(PG8_SB(1, 1), cB + hstep + ks, voffB);
    PG8_WAIT_V(6); PG8_BAR;
#endif
    for (;;) {
        const bool has_next = S.next(ui + 1, nxt);
        const unsigned nks = has_next ? 0u - ks : ks, nrev = (nks != kstep) ? (unsigned)(nt - 1) * kstep : 0u;
        const unsigned nA = has_next ? (unsigned)nxt.pm * tstep + nrev : cA, nB = has_next ? (unsigned)nxt.pn * tstep + nrev : cB;
        for (int t = 0; t < nt; t += 2) {
            const bool last = (t == nt - 2);
            const unsigned a1 = cA + (unsigned)(t + 1) * ks;
            const unsigned a2 = last ? nA : cA + (unsigned)(t + 2) * ks, b2 = last ? nB : cB + (unsigned)(t + 2) * ks;
            const unsigned a3 = a2 + (last ? nks : ks), b3 = b2 + (last ? nks : ks);
#if KL_SP2
            PG8_LDB(B0, 0, 0); PG8_LDB(B1, 0, 1); PG8_SCHED; PG8_LDA(At, 0, 0); PG8_STAGE(PG8_SA(1, 1), a1 + hstep, voffA);
            PG8_WAIT_V(8); PG8_WAIT_L(0); PG8_BAR; if (t == 0) { PG8_MMAZ(0, 0, At, B0); PG8_MMAZ(0, 1, At, B1); } else { PG8_MMA(0, 0, At, B0); PG8_MMA(0, 1, At, B1); } PG8_BAR; PG8_SCHED;
            PG8_LDA(At, 0, 1); PG8_STAGE(PG8_SB(0, 0), b2, voffB); PG8_STAGE(PG8_SB(0, 1), b2 + hstep, voffB); PG8_STAGE(PG8_SA(0, 0), a2, voffA);
            PG8_WAIT_V(8); PG8_WAIT_L(0); PG8_BAR; if (t == 0) { PG8_MMAZ(1, 0, At, B0); PG8_MMAZ(1, 1, At, B1); } else { PG8_MMA(1, 0, At, B0); PG8_MMA(1, 1, At, B1); } PG8_BAR; PG8_SCHED;
            PG8_LDB(B0, 1, 0); PG8_LDB(B1, 1, 1); PG8_SCHED; PG8_LDA(At, 1, 0); PG8_STAGE(PG8_SA(0, 1), a2 + hstep, voffA);
            PG8_WAIT_V(8); PG8_WAIT_L(0); PG8_BAR; PG8_MMA(0, 0, At, B0); PG8_MMA(0, 1, At, B1); PG8_BAR; PG8_SCHED;
            PG8_LDA(At, 1, 1); PG8_STAGE(PG8_SB(1, 0), b3, voffB); PG8_STAGE(PG8_SB(1, 1), b3 + hstep, voffB); PG8_STAGE(PG8_SA(1, 0), a3, voffA);
            PG8_WAIT_V(8); PG8_WAIT_L(0); PG8_BAR; PG8_MMA(1, 0, At, B0); PG8_MMA(1, 1, At, B1); PG8_BAR; PG8_SCHED;
#else
            PG8_LDB(B0, 0, 0); PG8_SCHED; PG8_LDA(At, 0, 0); PG8_STAGE(PG8_SA(1, 1), a1 + hstep, voffA);
            PG8_WAIT_L(8); PG8_BAR; PG8_WAIT_L(0); PG8_MMA(0, 0, At, B0); PG8_BAR; PG8_SCHED;
            PG8_LDB(B1, 0, 1); PG8_STAGE(PG8_SB(0, 0), b2, voffB);
            PG8_BAR; PG8_WAIT_L(0); PG8_MMA(0, 1, At, B1); PG8_BAR;
            PG8_LDA(At, 0, 1); PG8_STAGE(PG8_SA(0, 0), a2, voffA);
            PG8_BAR; PG8_WAIT_L(0); PG8_MMA(1, 0, At, B0); PG8_BAR; PG8_SCHED;
            PG8_STAGE(PG8_SB(0, 1), b2 + hstep, voffB);
            PG8_WAIT_V(6); PG8_BAR; PG8_MMA(1, 1, At, B1); PG8_BAR;
            PG8_LDB(B0, 1, 0); PG8_SCHED; PG8_LDA(At, 1, 0); PG8_STAGE(PG8_SA(0, 1), a2 + hstep, voffA);
            PG8_WAIT_L(8); PG8_BAR; PG8_WAIT_L(0); PG8_MMA(0, 0, At, B0); PG8_BAR; PG8_SCHED;
            PG8_LDB(B1, 1, 1); PG8_STAGE(PG8_SB(1, 0), b3, voffB);
            PG8_BAR; PG8_WAIT_L(0); PG8_MMA(0, 1, At, B1); PG8_BAR;
            PG8_LDA(At, 1, 1); PG8_STAGE(PG8_SA(1, 0), a3, voffA);
            PG8_BAR; PG8_WAIT_L(0); PG8_MMA(1, 0, At, B0); PG8_BAR; PG8_SCHED;
            PG8_STAGE(PG8_SB(1, 1), b3 + hstep, voffB);
            PG8_WAIT_V(6); PG8_BAR; PG8_MMA(1, 1, At, B1); PG8_BAR;
#endif
        }
        if (KL_ALIGN && wr == 0) PG8_BAR;
        E(acc, cur, wr, wc, fr, fq, (const LAS float*)(lds + RS_OFF) + slot * 256);
        if (!has_next) break;
        if constexpr (Epi::NEEDS_RS) { if (nxt.pm != cur.pm) { slot ^= 1; prep_rstd(E.SS, nxt.pm, (LAS float*)(lds + RS_OFF) + slot * 256, tid); } }
        cur = nxt; cA = nA; cB = nB; ks = nks; ++ui;
        if (KL_ALIGN && wr == 1) PG8_BAR;
    }
    PG8_WAIT_V(0);
    if (!KL_ALIGN && wr == 0) PG8_BAR;
    PG8_BAR;
#undef PG8_SA
#undef PG8_SB
#undef PG8_STAGE
#undef PG8_LDA
#undef PG8_LDB
#undef PG8_MMA
#undef PG8_MMAZ
#undef PG8_WAIT_V
#undef PG8_WAIT_L
#undef PG8_BAR
#undef PG8_SCHED
}
}

struct Args { const float* in[21]; float* out; unsigned char* ws; };
enum { I_X = 0, I_ENORM, I_EWIN, I_LNG, I_LNB, I_SWS, I_SBS, I_PW, I_PB, I_PS, I_EWOUT, I_ONORM, I_OWIN, I_CW, I_CB, I_OWOUT, I_FNORM, I_WG, I_WU, I_WD, I_FINAL };

__device__ __forceinline__ void tr_item(const float* W, int ldw, int k0, int c0, const float* ks, bf16* WT, int K, int drow0, LAS float* scr, int lane) {
    f32x4 v[8]; float sc[8];
    const int kq = lane >> 3, n4 = (lane & 7) * 4;
#pragma unroll
    for (int i = 0; i < 8; ++i) { const int kk = 8 * i + kq; v[i] = __builtin_nontemporal_load((const f32x4*)(W + (size_t)(k0 + kk) * ldw + c0 + n4)); sc[i] = ks ? ks[k0 + kk] : 1.0f; }
#pragma unroll
    for (int i = 0; i < 8; ++i) { const int kk = 8 * i + kq; LAS float* d = scr + kk * 33 + n4; d[0] = v[i].x * sc[i]; d[1] = v[i].y * sc[i]; d[2] = v[i].z * sc[i]; d[3] = v[i].w * sc[i]; }
    asm volatile("s_waitcnt lgkmcnt(0)" ::: "memory");
    const int c = lane & 7;
#pragma unroll
    for (int j = 0; j < 4; ++j) { const int n = (lane >> 3) + 8 * j; const LAS float* s = scr + (8 * c) * 33 + n;
        u32x4 o; o.x = cvt_pk_bf16(s[0 * 33], s[1 * 33]); o.y = cvt_pk_bf16(s[2 * 33], s[3 * 33]); o.z = cvt_pk_bf16(s[4 * 33], s[5 * 33]); o.w = cvt_pk_bf16(s[6 * 33], s[7 * 33]);
        *(u32x4*)(WT + (size_t)(drow0 + n) * K + k0 + 8 * c) = o; }
    asm volatile("s_waitcnt lgkmcnt(0)" ::: "memory");
}

__device__ __forceinline__ void prologue(const Args& a, LAS unsigned char* lds, int wave, int lane) {
    LAS float* scr = (LAS float*)(lds + wave * 16384);
    const int gw = blockIdx.x * 8 + wave, NGW = gridDim.x * 8;
    unsigned char* ws = a.ws;
    constexpr int KB = D / 64;
    constexpr int I1 = KB * (N_IN0 / 32), I2 = KB * (D / 32), I3 = KB * (N_GU / 32), I4 = (FF / 64) * (D / 32), I5 = KB * (N_IN1 / 32), I6 = I2, I7 = I3, I8 = I4, I9 = 4 * 2 * 4, I10 = 128;
    constexpr int NITEMS = I1 + I2 + I3 + I4 + I5 + I6 + I7 + I8 + I9 + I10;
    for (int it = gw; it < NITEMS; it += NGW) {
        int r = it;
        if (r < I1) { const int nb = r % (N_IN0 / 32), kb = r / (N_IN0 / 32); tr_item(a.in[I_EWIN], N_IN0, kb * 64, nb * 32, a.in[I_ENORM], (bf16*)(ws + WS_W1), D, nb * 32, scr, lane); continue; } r -= I1;
        if (r < I2) { const int nb = r % (D / 32), kb = r / (D / 32); tr_item(a.in[I_EWOUT], D, kb * 64, nb * 32, nullptr, (bf16*)(ws + WS_W2), D, nb * 32, scr, lane); continue; } r -= I2;
        if (r < I3 + I4) {
            if (r < I3) { const int nb = r % (N_GU / 32), kb = r / (N_GU / 32), np = nb * 32, pn = np >> 8, bj = (np >> 7) & 1, j0 = np & 127;
                tr_item(bj ? a.in[I_WU] : a.in[I_WG], FF, kb * 64, pn * 128 + j0, a.in[I_FNORM], (bf16*)(ws + WS_W3), D, np, scr, lane); continue; }
            r -= I3; { const int nb = r % (D / 32), kb = r / (D / 32); tr_item(a.in[I_WD], D, kb * 64, nb * 32, nullptr, (bf16*)(ws + WS_W4), FF, nb * 32, scr, lane); continue; }
        } r -= I3 + I4;
        if (r < I5) { const int nb = r % (N_IN1 / 32), kb = r / (N_IN1 / 32), np = nb * 32, pn = np >> 8;
            const int c0 = pn < 8 ? ((((np >> 7) & 1) ? 2048 : 1024) + pn * 128 + (np & 127)) : ((pn - 8) * 256 + (np & 255));
            tr_item(a.in[I_OWIN], N_IN1, kb * 64, c0, a.in[I_ONORM], (bf16*)(ws + WS_W5), D, np, scr, lane); continue; } r -= I5;
        if (r < I6) { const int nb = r % (D / 32), kb = r / (D / 32); tr_item(a.in[I_OWOUT], D, kb * 64, nb * 32, nullptr, (bf16*)(ws + WS_W6), D, nb * 32, scr, lane); continue; } r -= I6;
        if (r < I7 + I8) {
            if (r < I7) { const int nb = r % (N_GU / 32), kb = r / (N_GU / 32), np = nb * 32, pn = np >> 8, bj = (np >> 7) & 1, j0 = np & 127;
                tr_item((bj ? a.in[I_WU] : a.in[I_WG]) + (size_t)D * FF, FF, kb * 64, pn * 128 + j0, a.in[I_FNORM] + D, (bf16*)(ws + WS_W7), D, np, scr, lane); continue; }
            r -= I7; { const int nb = r % (D / 32), kb = r / (D / 32); tr_item(a.in[I_WD] + (size_t)FF * D, D, kb * 64, nb * 32, nullptr, (bf16*)(ws + WS_W8), FF, nb * 32, scr, lane); continue; }
        } r -= I7 + I8;
        if (r < I9) { const int g = r >> 3, kb = (r >> 2) & 1, nb = r & 3;
            tr_item(a.in[I_PW] + (size_t)g * 128 * 128, 128, kb * 64, nb * 32, nullptr, (bf16*)(ws + WS_PWT) + (size_t)g * 128 * 128, 128, nb * 32, scr, lane); continue; } r -= I9;
        {
            const int idx = r * 512 + lane * 8, i = (idx >> 7) & 127, j = idx & 127;
            const f32x4 v0 = *(const f32x4*)(a.in[I_SWS] + idx), v1 = *(const f32x4*)(a.in[I_SWS] + idx + 4);
            u32x4 o; o.x = cvt_pk_bf16(v0[0], v0[1]); o.y = cvt_pk_bf16(v0[2], v0[3]); o.z = cvt_pk_bf16(v1[0], v1[1]); o.w = cvt_pk_bf16(v1[2], v1[3]);
            if ((j >> 6) > (i >> 6)) o = (u32x4){0u, 0u, 0u, 0u};
            *(u32x4*)((bf16*)(ws + WS_WSM) + idx) = o;
        }
    }
    bf16* XB = (bf16*)(ws + WS_XBA); float* SS0 = (float*)(ws + WS_SS);
    for (int m0 = gw * 4; m0 < M; m0 += NGW * 4) {
        f32x4 v[4][4];
#pragma unroll
        for (int r = 0; r < 4; ++r)
#pragma unroll
            for (int j = 0; j < 4; ++j) v[r][j] = __builtin_nontemporal_load((const f32x4*)(a.in[I_X] + (size_t)(m0 + r) * D) + lane + 64 * j);
#pragma unroll
        for (int r = 0; r < 4; ++r) { float s = 0.f;
#pragma unroll
            for (int j = 0; j < 4; ++j) s += (v[r][j].x * v[r][j].x + v[r][j].y * v[r][j].y) + (v[r][j].z * v[r][j].z + v[r][j].w * v[r][j].w);
            s = wave_sum(s);
            u32x2* o8 = (u32x2*)(XB + (size_t)(m0 + r) * D) + lane;
#pragma unroll
            for (int j = 0; j < 4; ++j) { u32x2 w; w.x = cvt_pk_bf16(v[r][j].x, v[r][j].y); w.y = cvt_pk_bf16(v[r][j].z, v[r][j].w); o8[64 * j] = w; }
            if (lane < 16) SS0[(size_t)(m0 + r) * 16 + lane] = lane == 0 ? s : 0.f; }
    }
}

constexpr int TS = 272;
constexpr int MX_VT0 = 0, MX_VT1 = 128 * TS, MX_PL = 2 * 128 * TS, MX_DL = MX_PL + 144 * TS, MX_ST = MX_DL + 128 * TS;
static_assert(MX_ST + 1024 <= MISC_OFF, "mixer LDS map");
__device__ __forceinline__ void unpack8(const u32x4 v, float (&f)[8]) { f[0] = bf_lo(v.x); f[1] = bf_hi(v.x); f[2] = bf_lo(v.y); f[3] = bf_hi(v.y); f[4] = bf_lo(v.z); f[5] = bf_hi(v.z); f[6] = bf_lo(v.w); f[7] = bf_hi(v.w); }
__device__ __forceinline__ void mixer_phase(const Args& a, LAS unsigned char* lds, int tid, int wave, int lane) {
    unsigned char* ws = a.ws;
    const bf16* H0 = (const bf16*)(ws + WS_H0); bf16* MIX = (bf16*)(ws + WS_MIX);
    const bf16* WsM = (const bf16*)(ws + WS_WSM); const bf16* PwT = (const bf16*)(ws + WS_PWT);
    LAS float* st_mu = (LAS float*)(lds + MX_ST); LAS float* st_rs = st_mu + 128;
    LAS unsigned char* Pl = lds + MX_PL; LAS unsigned char* Dl = lds + MX_DL;
    const int fr = lane & 15, fq = lane >> 4;
    for (int blk = blockIdx.x; blk < M / 128; blk += gridDim.x) {
        const int R0 = blk * 128;
        const int tseq0 = (blk & (SEQ / 128 - 1)) * 128;
        u32x4 zr[16];
#pragma unroll
        for (int i = 0; i < 16; ++i) zr[i] = *(const u32x4*)(H0 + (size_t)(R0 + 16 * wave + i) * N_IN0 + 512 + lane * 8);
        u32x4 zq[2][2];
#pragma unroll
        for (int it = 0; it < 2; ++it) { const int c = (wave + 8 * it) * 8;
            zq[it][0] = *(const u32x4*)(H0 + (size_t)(R0 + 2 * lane) * N_IN0 + 512 + c); zq[it][1] = *(const u32x4*)(H0 + (size_t)(R0 + 2 * lane + 1) * N_IN0 + 512 + c); }
#pragma unroll
        for (int i = 0; i < 16; ++i) { float z[8]; unpack8(zr[i], z);
            float s = 0.f, q = 0.f;
#pragma unroll
            for (int e = 0; e < 8; ++e) { s += z[e]; q += z[e] * z[e]; }
#pragma unroll
            for (int o = 1; o < 64; o <<= 1) { s += __shfl_xor(s, o); q += __shfl_xor(q, o); }
            const float mean = s * (1.0f / 512.0f), var = fmaxf(q * (1.0f / 512.0f) - mean * mean, 0.f);
            if (lane == 0) { st_mu[16 * wave + i] = mean; st_rs[16 * wave + i] = __builtin_amdgcn_rsqf(var + EPS); } }
        __syncthreads();
        u32x4 pq[5];
#pragma unroll
        for (int h = 0; h < 4; ++h) {
            LAS unsigned char* buf = lds + ((h & 1) ? MX_VT1 : MX_VT0);
            {   const int j = 2 * lane; const float m0 = st_mu[j], s0 = st_rs[j], m1 = st_mu[j + 1], s1 = st_rs[j + 1];
#pragma unroll
                for (int it = 0; it < 2; ++it) { const int doct = wave + 8 * it, c = h * 128 + doct * 8;
                    const f32x4 g0 = *(const f32x4*)(a.in[I_LNG] + c), g1 = *(const f32x4*)(a.in[I_LNG] + c + 4), b0 = *(const f32x4*)(a.in[I_LNB] + c), b1 = *(const f32x4*)(a.in[I_LNB] + c + 4);
                    float za[8], zb[8]; unpack8(zq[it][0], za); unpack8(zq[it][1], zb);
                    const float gg[8] = {g0[0], g0[1], g0[2], g0[3], g1[0], g1[1], g1[2], g1[3]}, bb[8] = {b0[0], b0[1], b0[2], b0[3], b1[0], b1[1], b1[2], b1[3]};
#pragma unroll
                    for (int e = 0; e < 8; ++e) { const float va = (za[e] - m0) * s0 * gg[e] + bb[e], vb = (zb[e] - m1) * s1 * gg[e] + bb[e];
                        *(LAS unsigned*)(buf + (doct * 8 + e) * TS + j * 2) = cvt_pk_bf16(va, vb); } } }
            const int i0 = 16 * wave, nks = wave < 4 ? 2 : 4;
            bf16x8 wf[4];
#pragma unroll
            for (int ks = 0; ks < 4; ++ks) wf[ks] = *(const bf16x8*)(WsM + (size_t)(h * 128 + i0 + fr) * 128 + ks * 32 + fq * 8);
            const size_t rrow = (size_t)(R0 + i0 + fr);
            u32x2 ur[8];
#pragma unroll
            for (int dt = 0; dt < 8; ++dt) ur[dt] = *(const u32x2*)(H0 + rrow * N_IN0 + h * 128 + dt * 16 + 4 * fq);
            const float bsv = a.in[I_SBS][(i0 + fr) * 4 + h];
            if (h < 3) {
#pragma unroll
                for (int it = 0; it < 2; ++it) { const int c = (h + 1) * 128 + (wave + 8 * it) * 8;
                    zq[it][0] = *(const u32x4*)(H0 + (size_t)(R0 + 2 * lane) * N_IN0 + 512 + c); zq[it][1] = *(const u32x4*)(H0 + (size_t)(R0 + 2 * lane + 1) * N_IN0 + 512 + c); }
            } else {
#pragma unroll
                for (int it = 0; it < 5; ++it) { const int task = tid + 512 * it, rr = task >> 4, oc = task & 15, t = rr - 16; pq[it] = (u32x4){0u, 0u, 0u, 0u};
                    if (task < 144 * 16 && tseq0 + t >= 0) pq[it] = *(const u32x4*)(H0 + (size_t)(R0 + t) * N_IN0 + 1024 + oc * 8); }
            }
            __syncthreads();
            f32x4 acc[8];
#pragma unroll
            for (int dt = 0; dt < 8; ++dt) acc[dt] = (f32x4){0.f, 0.f, 0.f, 0.f};
#pragma unroll
            for (int ks = 0; ks < 4; ++ks) if (ks < nks) {
#pragma unroll
                for (int dt = 0; dt < 8; ++dt) { const bf16x8 vf = *(const LAS bf16x8*)(buf + (dt * 16 + fr) * TS + (ks * 32 + fq * 8) * 2);
                    acc[dt] = __builtin_amdgcn_mfma_f32_16x16x32_bf16(vf, wf[ks], acc[dt], 0, 0, 0); } }
#pragma unroll
            for (int dt = 0; dt < 8; ++dt) { const int col = h * 128 + dt * 16 + 4 * fq;
                u32x2 w; w.x = cvt_pk_bf16(bf_lo(ur[dt].x) * (acc[dt][0] + bsv), bf_hi(ur[dt].x) * (acc[dt][1] + bsv)); w.y = cvt_pk_bf16(bf_lo(ur[dt].y) * (acc[dt][2] + bsv), bf_hi(ur[dt].y) * (acc[dt][3] + bsv));
                *(u32x2*)(MIX + rrow * D + col) = w; }
        }
#pragma unroll
        for (int g = 0; g < 4; ++g) {
            const int win = 2 << g;
#pragma unroll
            for (int it = 0; it < 5; ++it) { const int task = tid + 512 * it, rr = task >> 4, oc = task & 15; if (task < 144 * 16) *(LAS u32x4*)(Pl + rr * TS + oc * 16) = pq[it]; }
            bf16x8 wf[4];
#pragma unroll
            for (int ks = 0; ks < 4; ++ks) wf[ks] = *(const bf16x8*)(PwT + (size_t)(g * 128 + wave * 16 + fr) * 128 + ks * 32 + fq * 8);
            const int n = g * 128 + wave * 16 + 4 * fq;
            const f32x4 pb = *(const f32x4*)(a.in[I_PB] + n), ps = *(const f32x4*)(a.in[I_PS] + n);
            if (g < 3) {
#pragma unroll
                for (int it = 0; it < 5; ++it) { const int task = tid + 512 * it, rr = task >> 4, oc = task & 15, t = rr - 16; pq[it] = (u32x4){0u, 0u, 0u, 0u};
                    if (task < 144 * 16 && tseq0 + t >= 0) pq[it] = *(const u32x4*)(H0 + (size_t)(R0 + t) * N_IN0 + 1024 + (g + 1) * 128 + oc * 8); }
            }
            __syncthreads();
#pragma unroll
            for (int it = 0; it < 4; ++it) { const int task = tid + 512 * it, t = task >> 4, oc = task & 15;
                float s[8] = {0.f, 0.f, 0.f, 0.f, 0.f, 0.f, 0.f, 0.f}; u32x4 cur = (u32x4){0u, 0u, 0u, 0u};
#pragma unroll
                for (int k = 0; k < 16; ++k) if (k < win) { const u32x4 v = *(const LAS u32x4*)(Pl + (16 + t - k) * TS + oc * 16); if (k == 0) cur = v;
                    s[0] += bf_lo(v.x); s[1] += bf_hi(v.x); s[2] += bf_lo(v.y); s[3] += bf_hi(v.y); s[4] += bf_lo(v.z); s[5] += bf_hi(v.z); s[6] += bf_lo(v.w); s[7] += bf_hi(v.w); }
                const int cnt = (tseq0 + t + 1) < win ? (tseq0 + t + 1) : win; const float ic = 1.0f / (float)cnt;
                u32x4 o; o.x = cvt_pk_bf16(s[0] * ic - bf_lo(cur.x), s[1] * ic - bf_hi(cur.x)); o.y = cvt_pk_bf16(s[2] * ic - bf_lo(cur.y), s[3] * ic - bf_hi(cur.y));
                o.z = cvt_pk_bf16(s[4] * ic - bf_lo(cur.z), s[5] * ic - bf_hi(cur.z)); o.w = cvt_pk_bf16(s[6] * ic - bf_lo(cur.w), s[7] * ic - bf_hi(cur.w));
                *(LAS u32x4*)(Dl + t * TS + oc * 16) = o; }
            __syncthreads();
#pragma unroll 2
            for (int tt = 0; tt < 8; ++tt) { f32x4 acc = (f32x4){0.f, 0.f, 0.f, 0.f};
#pragma unroll
                for (int ks = 0; ks < 4; ++ks) { const bf16x8 df = *(const LAS bf16x8*)(Dl + (tt * 16 + fr) * TS + (ks * 32 + fq * 8) * 2);
                    acc = __builtin_amdgcn_mfma_f32_16x16x32_bf16(wf[ks], df, acc, 0, 0, 0); }
                u32x2 w; w.x = cvt_pk_bf16((acc[0] + pb[0]) * ps[0], (acc[1] + pb[1]) * ps[1]); w.y = cvt_pk_bf16((acc[2] + pb[2]) * ps[2], (acc[3] + pb[3]) * ps[3]);
                *(u32x2*)(MIX + (size_t)(R0 + tt * 16 + fr) * D + 512 + n) = w; }
        }
        __syncthreads();
    }
}

__device__ __forceinline__ void conv_phase(const Args& a, int tid) {
    unsigned char* ws = a.ws;
    const bf16* Q1 = (const bf16*)(ws + WS_Q1); const bf16* BG = (const bf16*)(ws + WS_BG); bf16* CV = (bf16*)(ws + WS_CV);
    const int oc = tid & 127, rsub = tid >> 7, c = oc * 8;
    float w0[8], w1[8], w2[8], cb[8];
    { const float* cw = a.in[I_CW]; const float* cbp = a.in[I_CB];
#pragma unroll
      for (int e = 0; e < 8; ++e) { w0[e] = cw[c + e]; w1[e] = cw[D + c + e]; w2[e] = cw[2 * D + c + e]; cb[e] = cbp[c + e]; } }
    for (int ch = blockIdx.x; ch < M / 64; ch += gridDim.x) {
        const int r0 = ch * 64 + rsub * 16;
        u32x4 qv[18], bv[16];
        const bool first = (r0 & (SEQ - 1)) == 0;
        qv[0] = (u32x4){0u, 0u, 0u, 0u}; qv[1] = qv[0];
        if (!first) { qv[0] = *(const u32x4*)(Q1 + (size_t)(r0 - 2) * D + c); qv[1] = *(const u32x4*)(Q1 + (size_t)(r0 - 1) * D + c); }
#pragma unroll
        for (int i = 0; i < 16; ++i) { const size_t off = (size_t)(r0 + i) * D + c; qv[i + 2] = *(const u32x4*)(Q1 + off); bv[i] = *(const u32x4*)(BG + off); }
        float qm2[8], qm1[8]; unpack8(qv[0], qm2); unpack8(qv[1], qm1);
#pragma unroll
        for (int i = 0; i < 16; ++i) { const size_t off = (size_t)(r0 + i) * D + c;
            float q[8], b[8]; unpack8(qv[i + 2], q); unpack8(bv[i], b);
            float y[8];
#pragma unroll
            for (int e = 0; e < 8; ++e) { y[e] = b[e] * (cb[e] + w0[e] * qm2[e] + w1[e] * qm1[e] + w2[e] * q[e]); qm2[e] = qm1[e]; qm1[e] = q[e]; }
            u32x4 o; o.x = cvt_pk_bf16(y[0], y[1]); o.y = cvt_pk_bf16(y[2], y[3]); o.z = cvt_pk_bf16(y[4], y[5]); o.w = cvt_pk_bf16(y[6], y[7]);
            *(u32x4*)(CV + off) = o; }
    }
}

__device__ __forceinline__ void final_phase(const Args& a, float* dst, int wave, int lane) {
    const float* SS = (const float*)(a.ws + WS_SS + 4 * SS_BYTES); const bf16* X4 = (const bf16*)(a.ws + WS_XBA);
    const int gw = blockIdx.x * 8 + wave, NGW = gridDim.x * 8;
    f32x4 g[2][2];
#pragma unroll
    for (int j = 0; j < 2; ++j) { g[j][0] = *(const f32x4*)(a.in[I_FINAL] + j * 512 + lane * 8); g[j][1] = *(const f32x4*)(a.in[I_FINAL] + j * 512 + lane * 8 + 4); }
    for (int m0 = gw * 4; m0 < M; m0 += NGW * 4) {
        f32x4 p[4]; u32x4 v[4][2];
#pragma unroll
        for (int r = 0; r < 4; ++r) { p[r] = *(const f32x4*)(SS + (size_t)(m0 + r) * 16 + 4 * (lane & 3));
#pragma unroll
            for (int j = 0; j < 2; ++j) v[r][j] = *(const u32x4*)(X4 + (size_t)(m0 + r) * D + j * 512 + lane * 8); }
#pragma unroll
        for (int r = 0; r < 4; ++r) { float s = (p[r].x + p[r].y) + (p[r].z + p[r].w); s += __shfl_xor(s, 1); s += __shfl_xor(s, 2);
            const float rstd = __builtin_amdgcn_rsqf(s * (1.0f / 1024.0f) + EPS);
#pragma unroll
            for (int j = 0; j < 2; ++j) { float* o = dst + (size_t)(m0 + r) * D + j * 512 + lane * 8;
                __builtin_nontemporal_store((f32x4){bf_lo(v[r][j].x), bf_hi(v[r][j].x), bf_lo(v[r][j].y), bf_hi(v[r][j].y)} * rstd * g[j][0], (f32x4*)o);
                __builtin_nontemporal_store((f32x4){bf_lo(v[r][j].z), bf_hi(v[r][j].z), bf_lo(v[r][j].w), bf_hi(v[r][j].w)} * rstd * g[j][1], (f32x4*)(o + 4)); } }
    }
}

template <int layer>
__device__ __forceinline__ void layer_tail(const Args& a, LAS unsigned char* lds, const XcdBarrier& xb, int tid, int G, int c) {
    unsigned char* ws = a.ws;
    float* SS = (float*)(ws + WS_SS);
    constexpr size_t SSF = SS_BYTES / 4;
    if (layer == 1) {
        {
            pg8::Gemm g{(const bf16*)(ws + WS_XBA), (const bf16*)(ws + WS_W5), M, 2 * D, D}; pg8::StaticOrder S; S.init(M, 2 * D, G, c);
            pg8::EpiQ E{(bf16*)(ws + WS_Q1), SS + 2 * SSF};
            pg8::gemm_phase(lds, g, S, E);
        }
        xcd_barrier(xb);
        {
            pg8::Gemm g{(const bf16*)(ws + WS_XBA), (const bf16*)(ws + WS_W5) + (size_t)2 * D * D, M, D, D}; pg8::StaticOrder S; S.init(M, D, G, c); S.rev = 1;
            pg8::EpiConvGate E{(const bf16*)(ws + WS_Q1), (bf16*)(ws + WS_CV), SS + 2 * SSF, a.in[I_CW], a.in[I_CB]};
            pg8::gemm_phase(lds, g, S, E);
        }
        xcd_barrier(xb);
    }
    {
        pg8::Gemm g{(const bf16*)(ws + (layer ? WS_CV : WS_MIX)), (const bf16*)(ws + (layer ? WS_W6 : WS_W2)), M, D, D}; pg8::StaticOrder S; S.init(M, D, G, c);
        pg8::EpiRes E{(const bf16*)(ws + WS_XBA), (bf16*)(ws + WS_XBB), SS + (layer ? 3 : 1) * SSF};
        if (DUP & 4) pg8::gemm_phase(lds, g, S, E);
        pg8::gemm_phase(lds, g, S, E);
    }
    xcd_barrier(xb);
    {
        pg8::Gemm g{(const bf16*)(ws + WS_XBB), (const bf16*)(ws + (layer ? WS_W7 : WS_W3)), M, N_GU, D}; pg8::StaticOrder S; S.init(M, N_GU, G, c);
        pg8::EpiSwiglu E{(bf16*)(ws + WS_ACT), SS + (layer ? 3 : 1) * SSF};
        pg8::gemm_phase(lds, g, S, E);
        if ((DUP & 2) && layer == 0) pg8::gemm_phase(lds, g, S, E);
        if ((DUP & 16) && layer == 0) { pg8::EpiNull E0{(float*)(ws + WS_END)}; pg8::StaticOrder S2 = S; S2.fixed = (DUP >> 12) & 1; pg8::gemm_phase<pg8::EpiNull, ((DUP >> 8) & 15)>(lds, g, S2, E0); }
    }
    xcd_barrier(xb);
    {
        pg8::Gemm g{(const bf16*)(ws + WS_ACT), (const bf16*)(ws + (layer ? WS_W8 : WS_W4)), M, D, FF}; pg8::StaticOrder S; S.init(M, D, G, c); S.rev = 1;
        pg8::EpiRes E{(const bf16*)(ws + WS_XBB), (bf16*)(ws + WS_XBA), SS + (layer ? 4 : 2) * SSF};
        if ((DUP & 8) && layer == 0) pg8::gemm_phase(lds, g, S, E);
        pg8::gemm_phase(lds, g, S, E);
    }
    xcd_barrier(xb);
}

__global__ void __launch_bounds__(512, 2) fwd_megakernel(Args a) {
    extern __shared__ __attribute__((aligned(16))) unsigned char lds_raw[];
    LAS unsigned char* lds = (LAS unsigned char*)lds_raw;
    cg::grid_group grid = cg::this_grid();
    const int tid = threadIdx.x, lane = tid & 63, wave = __builtin_amdgcn_readfirstlane(tid >> 6);
    unsigned char* ws = a.ws;
    const int G = gridDim.x, c = blockIdx.x;
    float* SS = (float*)(ws + WS_SS);
    constexpr size_t SSF = SS_BYTES / 4;

    if (tid < 32) ((volatile LAS unsigned*)(lds + MISC_OFF))[tid] = 0u;
    unsigned* barw = (unsigned*)(ws + WS_CTL);
    __syncthreads();
    const XcdBarrier xb = xcd_barrier_post(barw, (volatile LAS unsigned*)(lds + MISC_OFF) + 8);
    { int t_ = threadIdx.x; asm volatile("" : "+v"(t_)); prologue(a, lds, __builtin_amdgcn_readfirstlane(t_ >> 6), t_ & 63); }
    if (DUP & 32) { __syncthreads(); prologue(a, lds, wave, lane); }
    if (a.ws == nullptr) grid.sync();
    xcd_barrier(xb);
    {
        pg8::Gemm g{(const bf16*)(ws + WS_XBA), (const bf16*)(ws + WS_W1), M, N_IN0, D}; pg8::StaticOrder S; S.init(M, N_IN0, G, c);
        pg8::EpiNormAct E{(bf16*)(ws + WS_H0), N_IN0, SS, 4};
        pg8::gemm_phase(lds, g, S, E);
        if (DUP & 128) pg8::gemm_phase(lds, g, S, E);
    }
    xcd_barrier(xb);
    { int t_ = threadIdx.x; asm volatile("" : "+v"(t_)); mixer_phase(a, lds, t_, __builtin_amdgcn_readfirstlane(t_ >> 6), t_ & 63); }
    if (DUP & 64) { __syncthreads(); mixer_phase(a, lds, tid, wave, lane); }
    xcd_barrier(xb);
    layer_tail<0>(a, lds, xb, tid, G, c);
    layer_tail<1>(a, lds, xb, tid, G, c);
    if (DUP & 1) final_phase(a, (float*)(ws + WS_END), wave, lane);
    { int t_ = threadIdx.x; asm volatile("" : "+v"(t_)); final_phase(a, a.out, __builtin_amdgcn_readfirstlane(t_ >> 6), t_ & 63); }
}

extern "C" void kernel_launch(void* const* d_in, const int* in_sizes, int n_in, void* d_out, int out_size, void* d_ws, size_t ws_size, hipStream_t stream) {
    static int grid = 0;
    if (grid == 0) {
        if (n_in != 21 || in_sizes[0] != M * D || out_size != M * D || ws_size < WS_END) { fprintf(stderr, "kernel_launch: unexpected shapes (n_in %d, ws %zu)\n", n_in, ws_size); grid = -1; return; }
        int dev = 0, cus = 0, per_cu = 0;
        hipGetDevice(&dev);
        hipDeviceGetAttribute(&cus, hipDeviceAttributeMultiprocessorCount, dev);
        hipFuncSetAttribute((const void*)fwd_megakernel, hipFuncAttributeMaxDynamicSharedMemorySize, LDS_BYTES);
        hipOccupancyMaxActiveBlocksPerMultiprocessor(&per_cu, (const void*)fwd_megakernel, 512, LDS_BYTES);
        if (per_cu < 1) { fprintf(stderr, "kernel_launch: occupancy query says %d blocks per CU\n", per_cu); per_cu = 1; }
        (void)hipGetLastError();
        grid = cus;
    }
    if (grid < 0) return;
    if (hipMemsetAsync((char*)d_ws + WS_CTL, 0, XCD_BAR_WORDS * sizeof(unsigned), stream) != hipSuccess) { fprintf(stderr, "kernel_launch: memset of the barrier words failed\n"); return; }
    Args a{};
    for (int i = 0; i < 21; ++i) a.in[i] = (const float*)d_in[i];
    a.out = (float*)d_out; a.ws = (unsigned char*)d_ws;
    void* args[] = {&a};
    hipError_t e = hipLaunchCooperativeKernel((const void*)fwd_megakernel, dim3(grid), dim3(512), args, LDS_BYTES, stream);
    if (e != hipSuccess) fprintf(stderr, "cooperative launch failed: %s (grid %d)\n", hipGetErrorString(e), grid);
}
```

```cpp
#include <hip/hip_runtime.h>
#include <hip/hip_cooperative_groups.h>
#include <cstdio>
#include <cstdint>
namespace cg = cooperative_groups;
#ifndef DUP
#define DUP 0
#endif
#ifndef KL_SP2
#define KL_SP2 1
#endif
#ifndef KL_PRIO
#define KL_PRIO 1
#endif
#ifndef KL_ALIGN
#define KL_ALIGN 1
#endif

#define LAS __attribute__((address_space(3)))
typedef unsigned short bf16;
typedef short bf16x8 __attribute__((ext_vector_type(8)));
typedef float f32x4 __attribute__((ext_vector_type(4)));
typedef float f32x2 __attribute__((ext_vector_type(2)));
typedef unsigned u32x4 __attribute__((ext_vector_type(4)));
typedef unsigned u32x2 __attribute__((ext_vector_type(2)));

constexpr int M = 65536, D = 1024, FF = 2816, SEQ = 4096;
constexpr int N_IN0 = 1536, N_IN1 = 3072, N_GU = 2 * FF;
constexpr float EPS = 1e-6f;

constexpr size_t MiB = 1u << 20;
constexpr size_t WS_W1 = 0, WS_W2 = 3 * MiB, WS_W3 = 5 * MiB, WS_W4 = 16 * MiB, WS_W5 = 22 * MiB, WS_W6 = 28 * MiB, WS_W7 = 30 * MiB, WS_W8 = 41 * MiB;
constexpr size_t WS_WSM = 47 * MiB, WS_PWT = 47 * MiB + 128 * 1024;
constexpr size_t WS_CTL = 47 * MiB + 512 * 1024;
constexpr size_t WS_SS = 48 * MiB, SS_BYTES = 4 * MiB;
constexpr size_t WS_XBA = 68 * MiB, WS_XBB = 196 * MiB;
constexpr size_t WS_A = 324 * MiB;
constexpr size_t WS_H0 = WS_A, WS_MIX = WS_A + 192 * MiB, WS_ACT = WS_A, WS_Q1 = WS_A, WS_BG = WS_A + 128 * MiB, WS_CV = WS_A + 256 * MiB;
constexpr size_t WS_END = 708 * MiB;

constexpr int LDS_BYTES = 147456 + 256;
constexpr int MISC_OFF = 147456;

__device__ __forceinline__ unsigned cvt_pk_bf16(float lo, float hi) { unsigned r; asm volatile("v_cvt_pk_bf16_f32 %0, %1, %2" : "=v"(r) : "v"(lo), "v"(hi)); return r; }
__device__ __forceinline__ float bf_lo(unsigned w) { return __uint_as_float(w << 16); }
__device__ __forceinline__ float bf_hi(unsigned w) { return __uint_as_float(w & 0xffff0000u); }
__device__ __forceinline__ float wave_sum(float v) {
#pragma unroll
    for (int o = 1; o < 64; o <<= 1) v += __shfl_xor(v, o);
    return v;
}
__device__ __forceinline__ f32x2 gelu_pk(f32x2 v) {
    const f32x2 w = __builtin_elementwise_abs(v), x = w * 0.70710678118f;
    f32x2 p = x * 0.0000430638f + 0.0002765672f; p = p * x + 0.0001520143f; p = p * x + 0.0092705272f; p = p * x + 0.0422820123f; p = p * x + 0.0705230784f; p = p * x + 1.0f;
    f32x2 d = p * p; d = d * d; d = d * d; d = d * d;
    f32x2 q; q.x = __builtin_amdgcn_rcpf(d.x); q.y = __builtin_amdgcn_rcpf(d.y);
    const f32x2 t = w - w * q;
    return (v + t) * 0.5f;
}
__device__ __forceinline__ float silu_mul(float g, float u) { return g * __builtin_amdgcn_rcpf(1.0f + __builtin_amdgcn_exp2f(g * -1.44269504089f)) * u; }


#define XB_TMO      128
#define XB_XCNT(j)  (256  + 64 * (j))
#define XB_XSUB(j)  (1280 + 64 * (j))
#define XB_XGEN(j)  (2304 + 64 * (j))
#define XB_TOP      3328
#define XB_TOPGEN   3392
#define XCD_BAR_WORDS 3456
#define XB_SPIN_CAP (1u << 20)
__device__ __forceinline__ unsigned xb_ld(unsigned* p)              { return __hip_atomic_load(p, __ATOMIC_RELAXED, __HIP_MEMORY_SCOPE_AGENT); }
__device__ __forceinline__ unsigned xb_add(unsigned* p, unsigned v) { return __hip_atomic_fetch_add(p, v, __ATOMIC_RELAXED, __HIP_MEMORY_SCOPE_AGENT); }
__device__ __forceinline__ unsigned xb_xcc_id() { return (unsigned)__builtin_amdgcn_s_getreg((3 << 11) | 20) & 0xFu; }
#define XB_SPIN(cond, bar) do { unsigned _sp = 0; while (cond) { __builtin_amdgcn_s_sleep(1); \
    if ((++_sp & 255u) == 0u) { if (xb_ld(&(bar)[XB_TMO])) break; if (_sp > XB_SPIN_CAP) { atomicAdd(&(bar)[XB_TMO], 1u); break; } } } } while (0)
struct XcdBarrier { unsigned* bar; unsigned x; volatile LAS unsigned* st; };
__device__ __forceinline__ XcdBarrier xcd_barrier_post(unsigned* bar, volatile LAS unsigned* st) {
    XcdBarrier b; b.bar = bar; b.x = xb_xcc_id(); b.st = st;
    if (threadIdx.x == 0) (void)xb_add(&bar[XB_XCNT(b.x)], 1u);
    return b;
}
__device__ __forceinline__ void xcd_barrier_complete(unsigned* bar, unsigned x, unsigned& nloc, unsigned& nx) {
    const unsigned G = gridDim.x * gridDim.y * gridDim.z;
    unsigned sum, cnt, mine, sp = 0u;
    for (;;) {
        sum = 0u; cnt = 0u; mine = 0u;
#pragma unroll
        for (unsigned j = 0; j < 16; ++j) { const unsigned c = xb_ld(&bar[XB_XCNT(j)]); sum += c; cnt += (c > 0u) ? 1u : 0u; mine = (j == x) ? c : mine; }
        if (sum == G) break;
        __builtin_amdgcn_s_sleep(1);
        if ((++sp & 255u) == 0u) { if (xb_ld(&bar[XB_TMO])) break; if (sp > XB_SPIN_CAP) { atomicAdd(&bar[XB_TMO], 1u); break; } }
    }
    nloc = mine > 0u ? mine : 1u; nx = cnt > 0u ? cnt : 1u;
}
__device__ __forceinline__ void xcd_barrier(const XcdBarrier& b) {
    asm volatile("s_waitcnt vmcnt(0)" ::: "memory");
    __syncthreads();
    if (threadIdx.x == 0) {
        unsigned* bar = b.bar;
        __builtin_amdgcn_s_waitcnt(0);
        unsigned nloc = b.st[0], nx = b.st[1];
        if (nloc == 0u) { xcd_barrier_complete(bar, b.x, nloc, nx); b.st[0] = nloc; b.st[1] = nx; }
        const unsigned old = xb_add(&bar[XB_XSUB(b.x)], 1u);
        const unsigned gen = old / nloc;
        if (old + 1u == (gen + 1u) * nloc) {
            __builtin_amdgcn_fence(__ATOMIC_RELEASE, "agent");
            asm volatile("s_waitcnt vmcnt(0)" ::: "memory");
            const unsigned og = xb_add(&bar[XB_TOP], 1u);
            const unsigned tg = og / nx;
            if (og + 1u == (tg + 1u) * nx) xb_add(&bar[XB_TOPGEN], 1u);
            else XB_SPIN(xb_ld(&bar[XB_TOPGEN]) == tg, bar);
            __builtin_amdgcn_fence(__ATOMIC_ACQUIRE, "agent");
            xb_add(&bar[XB_XGEN(b.x)], 1u);
            asm volatile("s_waitcnt vmcnt(0)" ::: "memory");
        } else {
            XB_SPIN(xb_ld(&bar[XB_XGEN(b.x)]) == gen, bar);
            __builtin_amdgcn_fence(__ATOMIC_ACQUIRE, "agent");
            asm volatile("s_waitcnt vmcnt(0)" ::: "memory");
        }
    }
    __syncthreads();
}

namespace pg8 {
constexpr int BM = 256, BK = 64, HALF = 128, HTB = HALF * BK * 2, STAGE_BYTES = 8 * HTB, NXCD = 8, WGM = 8;
__host__ __device__ __forceinline__ int lds_byte(int r, int c) { const int st = (r >> 4) * 2 + (c >> 5), rr = r & 15, cc = c & 31, ob = rr * 64 + cc * 2; return st * 1024 + (ob ^ (((ob >> 9) & 1) << 5)); }
__host__ __device__ __forceinline__ void stage_rc(int b, int& R, int& C) { const int st = b / 1024, sb = b % 1024, swz = sb ^ (((sb >> 9) & 1) << 5); R = (st >> 1) * 16 + swz / 64; C = (st & 1) * 32 + (swz % 64) / 2; }
__host__ __device__ __forceinline__ int perm32(int rho) { const int n = rho >> 4, i = rho & 15; return 8 * (i >> 2) + 4 * n + (i & 3); }

struct Unit { int pm, pn; };
struct Gemm { const bf16* A; const bf16* Bt; int M, N, K; };

struct StaticOrder {
    int nM, nN, nwg, G, c; int fixed = 0; int rev = 0;
    __host__ __device__ void init(int M_, int N_, int G_, int c_) { nM = M_ / BM; nN = N_ / BM; nwg = nM * nN; G = G_; c = c_; }
    __host__ __device__ bool next(int i, Unit& u) const {
        if (rev && nwg % G == 0) { const int nr = nwg / G; if (i >= nr) return false; i = nr - 1 - i; }
        const long L = (long)i * G + c; if (L >= nwg) return false;
        int wgid = (int)L; { const int q = nwg / NXCD, r = nwg % NXCD, xcd = wgid % NXCD, off = wgid / NXCD; wgid = (xcd < r ? xcd * (q + 1) : r * (q + 1) + (xcd - r) * q) + off; }
        const int nig = WGM * nN, gid = wgid / nig, fm = gid * WGM, gsz = (nM - fm) < WGM ? (nM - fm) : WGM;
        u.pm = fm + ((wgid % nig) % gsz); u.pn = (wgid % nig) / gsz; if (fixed) { u.pm = c & 7; u.pn = 0; } return true;
    }
};

constexpr int RS_OFF = 131072;
__device__ __forceinline__ void prep_rstd(const float* SS, int pm, LAS float* rsl, int tid) {
    asm volatile("" : "+v"(tid));
    const int row = tid >> 1, hf = tid & 1;
    const f32x4* p = (const f32x4*)(SS + (size_t)(pm * BM + row) * 16 + hf * 8);
    const f32x4 s4 = p[0] + p[1]; float s = (s4.x + s4.y) + (s4.z + s4.w); s += __shfl_xor(s, 1);
    if (hf == 0) rsl[row] = __builtin_amdgcn_rsqf(s * (1.0f / 1024.0f) + EPS);
}
__device__ __forceinline__ void load_rstd(const LAS float* rsl, int rloc, float (&rs)[4]) {
#pragma unroll
    for (int m = 0; m < 4; ++m) rs[m] = rsl[rloc + m * 16];
}
struct EpiNormAct {
    static constexpr bool PERM = true, NEEDS_RS = true;
    bf16* O; int ldc; const float* SS; int gelu_tiles;
    __device__ __forceinline__ void operator()(const f32x4 (&acc)[2][2][4][2], const Unit& u, int wr, int wc, int fr, int fq, const LAS float* rsl) const {
        const int row0 = u.pm * BM + wr * 64 + fr, col0 = u.pn * BM + wc * 32 + 8 * fq;
        const bool act = u.pn < gelu_tiles;
#pragma unroll
        for (int ai = 0; ai < 2; ++ai) { float rs[4]; load_rstd(rsl, ai * HALF + wr * 64 + fr, rs);
#pragma unroll
            for (int m = 0; m < 4; ++m) { bf16* rowp = O + (size_t)(row0 + ai * HALF + m * 16) * ldc + col0; const float r = rs[m];
#pragma unroll
                for (int bj = 0; bj < 2; ++bj) { f32x4 v0 = acc[ai][bj][m][0] * r, v1 = acc[ai][bj][m][1] * r;
                    if (act) { f32x2 a = gelu_pk((f32x2){v0[0], v0[1]}), b = gelu_pk((f32x2){v0[2], v0[3]}), c = gelu_pk((f32x2){v1[0], v1[1]}), d = gelu_pk((f32x2){v1[2], v1[3]});
                        v0 = (f32x4){a.x, a.y, b.x, b.y}; v1 = (f32x4){c.x, c.y, d.x, d.y}; }
                    u32x4 w; w.x = cvt_pk_bf16(v0[0], v0[1]); w.y = cvt_pk_bf16(v0[2], v0[3]); w.z = cvt_pk_bf16(v1[0], v1[1]); w.w = cvt_pk_bf16(v1[2], v1[3]);
                    *(u32x4*)(rowp + bj * HALF) = w; }
                asm volatile("" ::: "memory"); } }
    }
};
struct EpiRes {
    static constexpr bool PERM = true, NEEDS_RS = false;
    const bf16* base; bf16* out; float* SS;
    __device__ __forceinline__ void operator()(const f32x4 (&acc)[2][2][4][2], const Unit& u, int wr, int wc, int fr, int fq, const LAS float* rsl) const {
        const int row0 = u.pm * BM + wr * 64 + fr, col0 = u.pn * BM + wc * 32 + 8 * fq;
#pragma unroll
        for (int ai = 0; ai < 2; ++ai) {
            u32x4 b[4][2];
#pragma unroll
            for (int m = 0; m < 4; ++m)
#pragma unroll
                for (int bj = 0; bj < 2; ++bj) b[m][bj] = *(const u32x4*)(base + (size_t)(row0 + ai * HALF + m * 16) * D + col0 + bj * HALF);
#pragma unroll
            for (int m = 0; m < 4; ++m) { const int row = row0 + ai * HALF + m * 16; const size_t off = (size_t)row * D + col0; float ssq = 0.f;
#pragma unroll
                for (int bj = 0; bj < 2; ++bj) { const u32x4 bb = b[m][bj];
                    const f32x4 o0 = acc[ai][bj][m][0] + (f32x4){bf_lo(bb.x), bf_hi(bb.x), bf_lo(bb.y), bf_hi(bb.y)}, o1 = acc[ai][bj][m][1] + (f32x4){bf_lo(bb.z), bf_hi(bb.z), bf_lo(bb.w), bf_hi(bb.w)};
                    ssq += ((o0[0] * o0[0] + o0[1] * o0[1]) + (o0[2] * o0[2] + o0[3] * o0[3])) + ((o1[0] * o1[0] + o1[1] * o1[1]) + (o1[2] * o1[2] + o1[3] * o1[3]));
                    u32x4 w; w.x = cvt_pk_bf16(o0[0], o0[1]); w.y = cvt_pk_bf16(o0[2], o0[3]); w.z = cvt_pk_bf16(o1[0], o1[1]); w.w = cvt_pk_bf16(o1[2], o1[3]);
                    *(u32x4*)(out + off + bj * HALF) = w; }
                ssq += __shfl_xor(ssq, 16); ssq += __shfl_xor(ssq, 32);
                if (fq == 0) SS[(size_t)row * 16 + u.pn * 4 + wc] = ssq; }
            asm volatile("" ::: "memory"); }
    }
};
struct EpiSwiglu {
    static constexpr bool PERM = true, NEEDS_RS = true;
    bf16* O; const float* SS;
    __device__ __forceinline__ f32x4 sw(const f32x4 g, const f32x4 u, float rl, float r2) const {
        const f32x4 t = g * rl; f32x4 d;
        d[0] = __builtin_amdgcn_exp2f(t[0]); d[1] = __builtin_amdgcn_exp2f(t[1]); d[2] = __builtin_amdgcn_exp2f(t[2]); d[3] = __builtin_amdgcn_exp2f(t[3]);
        d = d + 1.0f;
        f32x4 s; s[0] = __builtin_amdgcn_rcpf(d[0]); s[1] = __builtin_amdgcn_rcpf(d[1]); s[2] = __builtin_amdgcn_rcpf(d[2]); s[3] = __builtin_amdgcn_rcpf(d[3]);
        return (g * u) * r2 * s;
    }
    __device__ __forceinline__ void operator()(const f32x4 (&acc)[2][2][4][2], const Unit& u, int wr, int wc, int fr, int fq, const LAS float* rsl) const {
        const int row0 = u.pm * BM + wr * 64 + fr, col0 = u.pn * HALF + wc * 32 + 8 * fq;
#pragma unroll
        for (int ai = 0; ai < 2; ++ai) { float rs[4]; load_rstd(rsl, ai * HALF + wr * 64 + fr, rs);
#pragma unroll
            for (int m = 0; m < 4; ++m) { const float r = rs[m], rl = r * -1.44269504089f, r2 = r * r;
                const f32x4 o0 = sw(acc[ai][0][m][0], acc[ai][1][m][0], rl, r2), o1 = sw(acc[ai][0][m][1], acc[ai][1][m][1], rl, r2);
                u32x4 w; w.x = cvt_pk_bf16(o0[0], o0[1]); w.y = cvt_pk_bf16(o0[2], o0[3]); w.z = cvt_pk_bf16(o1[0], o1[1]); w.w = cvt_pk_bf16(o1[2], o1[3]);
                *(u32x4*)(O + (size_t)(row0 + ai * HALF + m * 16) * FF + col0) = w; asm volatile("" ::: "memory"); } }
    }
};
struct EpiNull { static constexpr bool PERM = true, NEEDS_RS = false; float* sink;
    __device__ __forceinline__ void operator()(const f32x4 (&acc)[2][2][4][2], const Unit& u, int wr, int wc, int fr, int fq, const LAS float* rsl) const {
        float s = 0.f;
#pragma unroll
        for (int ai = 0; ai < 2; ++ai)
#pragma unroll
            for (int m = 0; m < 4; ++m)
#pragma unroll
                for (int bj = 0; bj < 2; ++bj)
#pragma unroll
                    for (int n = 0; n < 2; ++n) s += acc[ai][bj][m][n][0] + acc[ai][bj][m][n][1] + acc[ai][bj][m][n][2] + acc[ai][bj][m][n][3];
        if (s == 123.456f) sink[0] = s; } };
struct EpiQ {
    static constexpr bool PERM = true, NEEDS_RS = true;
    bf16* Q1; const float* SS;
    __device__ __forceinline__ void operator()(const f32x4 (&acc)[2][2][4][2], const Unit& u, int wr, int wc, int fr, int fq, const LAS float* rsl) const {
        const int row0 = u.pm * BM + wr * 64 + fr;
        bf16* dst = Q1 + u.pn * HALF + wc * 32 + 8 * fq;
#pragma unroll
        for (int ai = 0; ai < 2; ++ai) { float rs[4]; load_rstd(rsl, ai * HALF + wr * 64 + fr, rs);
#pragma unroll
            for (int m = 0; m < 4; ++m) { const float r2 = rs[m] * rs[m];
                const f32x4 v0 = acc[ai][0][m][0] * acc[ai][1][m][0] * r2, v1 = acc[ai][0][m][1] * acc[ai][1][m][1] * r2;
                u32x4 w; w.x = cvt_pk_bf16(v0[0], v0[1]); w.y = cvt_pk_bf16(v0[2], v0[3]); w.z = cvt_pk_bf16(v1[0], v1[1]); w.w = cvt_pk_bf16(v1[2], v1[3]);
                *(u32x4*)(dst + (size_t)(row0 + ai * HALF + m * 16) * D) = w; }
            asm volatile("" ::: "memory"); }
    }
};
struct EpiConvGate {
    static constexpr bool PERM = true, NEEDS_RS = true;
    const bf16* Q1; bf16* CV; const float* SS; const float* cw; const float* cb;
    __device__ __forceinline__ void operator()(const f32x4 (&acc)[2][2][4][2], const Unit& u, int wr, int wc, int fr, int fq, const LAS float* rsl) const {
        int fq_ = fq, fr_ = fr; asm volatile("" : "+v"(fq_), "+v"(fr_));
        const int rloc0 = wr * 64 + fr_, row0 = u.pm * BM + rloc0;
        const u32x4 zero4 = (u32x4){0u, 0u, 0u, 0u};
#pragma unroll
        for (int bj = 0; bj < 2; ++bj) {
            const int c = u.pn * BM + bj * HALF + wc * 32 + 8 * fq_;
            const f32x4 w0a = *(const f32x4*)(cw + c), w0b = *(const f32x4*)(cw + c + 4), w1a = *(const f32x4*)(cw + D + c), w1b = *(const f32x4*)(cw + D + c + 4);
            const f32x4 w2a = *(const f32x4*)(cw + 2 * D + c), w2b = *(const f32x4*)(cw + 2 * D + c + 4), cba = *(const f32x4*)(cb + c), cbb = *(const f32x4*)(cb + c + 4);
#pragma unroll
            for (int ai = 0; ai < 2; ++ai) { float rs[4]; load_rstd(rsl, ai * HALF + rloc0, rs);
#pragma unroll
                for (int mp = 0; mp < 2; ++mp) {
                    u32x4 q[2][3];
#pragma unroll
                    for (int mm = 0; mm < 2; ++mm) { const int row = row0 + ai * HALF + (mp * 2 + mm) * 16, t = row & (SEQ - 1);
                        const bf16* p = Q1 + (size_t)row * D + c;
                        q[mm][0] = *(const u32x4*)p; q[mm][1] = *(const u32x4*)(t >= 1 ? p - D : p); q[mm][2] = *(const u32x4*)(t >= 2 ? p - 2 * D : p);
                        if (t < 1) q[mm][1] = zero4; if (t < 2) q[mm][2] = zero4; }
#pragma unroll
                    for (int mm = 0; mm < 2; ++mm) { const int m = mp * 2 + mm; const int row = row0 + ai * HALF + m * 16; const float r = rs[m];
                        const u32x4 a0 = q[mm][0], a1 = q[mm][1], a2 = q[mm][2];
                        const f32x4 ya = cba + w0a * (f32x4){bf_lo(a2.x), bf_hi(a2.x), bf_lo(a2.y), bf_hi(a2.y)} + w1a * (f32x4){bf_lo(a1.x), bf_hi(a1.x), bf_lo(a1.y), bf_hi(a1.y)} + w2a * (f32x4){bf_lo(a0.x), bf_hi(a0.x), bf_lo(a0.y), bf_hi(a0.y)};
                        const f32x4 yb = cbb + w0b * (f32x4){bf_lo(a2.z), bf_hi(a2.z), bf_lo(a2.w), bf_hi(a2.w)} + w1b * (f32x4){bf_lo(a1.z), bf_hi(a1.z), bf_lo(a1.w), bf_hi(a1.w)} + w2b * (f32x4){bf_lo(a0.z), bf_hi(a0.z), bf_lo(a0.w), bf_hi(a0.w)};
                        const f32x4 v0 = acc[ai][bj][m][0] * r * ya, v1 = acc[ai][bj][m][1] * r * yb;
                        u32x4 w; w.x = cvt_pk_bf16(v0[0], v0[1]); w.y = cvt_pk_bf16(v0[2], v0[3]); w.z = cvt_pk_bf16(v1[0], v1[1]); w.w = cvt_pk_bf16(v1[2], v1[3]);
                        *(u32x4*)(CV + (size_t)row * D + c) = w; }
                    asm volatile("" ::: "memory"); } }
        }
    }
};

template <class Epi, int PROBE = 0>
__device__ __forceinline__ void gemm_phase(LAS unsigned char* lds, const Gemm g, const StaticOrder& S, const Epi& E) {
    int tid_ = threadIdx.x; asm volatile("" : "+v"(tid_));
    const int tid = tid_, wid = __builtin_amdgcn_readfirstlane(tid >> 6), lane = tid & 63, wr = wid >> 2, wc = wid & 3, fr = lane & 15, fq = lane >> 4;
    const int K = g.K, nt = K / BK;
    unsigned voffA[2], voffB[2];
#pragma unroll
    for (int i = 0; i < 2; ++i) { int R, C; stage_rc(tid * 16 + i * 8192, R, C); const int Rb = Epi::PERM ? ((R & ~31) + perm32(R & 31)) : R;
        voffA[i] = (unsigned)(R * K + C) * 2u; voffB[i] = (unsigned)(Rb * K + C) * 2u; }
    const __amdgpu_buffer_rsrc_t rsA = __builtin_amdgcn_make_buffer_rsrc((void*)g.A, (short)0, (int)((size_t)g.M * K * 2), 0x00020000);
    const __amdgpu_buffer_rsrc_t rsB = __builtin_amdgcn_make_buffer_rsrc((void*)g.Bt, (short)0, (int)((size_t)g.N * K * 2), 0x00020000);
    const unsigned kstep = (unsigned)(BK * 2);
    const unsigned hstep = (unsigned)HALF * K * 2;
    const unsigned tstep = 2 * hstep;
    const unsigned ldsw = (unsigned)wid * 1024u;
    const int aoff = lds_byte(wr * 64 + fr, fq * 8), boff = lds_byte(wc * 32 + fr, fq * 8);
#define PG8_SA(b, h) (((b) * 2 + (h)) * HTB)
#define PG8_SB(b, h) ((4 + (b) * 2 + (h)) * HTB)
#define PG8_RS_voffA rsA
#define PG8_RS_voffB rsB
#define PG8_STAGE(bufoff, goff, voff) do { if (PROBE != 2) _Pragma("unroll") for (int _i = 0; _i < 2; ++_i) \
        __builtin_amdgcn_raw_ptr_buffer_load_lds(PG8_RS_##voff, (LAS void*)(lds + (bufoff) + ldsw + _i * 8192), 16, (int)(voff)[_i], (int)(goff), 0, 0); } while (0)
#define PG8_LDA(dst, b, h) do { _Pragma("unroll") for (int m = 0; m < 4; ++m) _Pragma("unroll") for (int k = 0; k < 2; ++k) dst[m][k] = *(const LAS bf16x8*)(lds + PG8_SA(b, h) + aoff + m * 2048 + k * 1024); } while (0)
#define PG8_LDB(dst, b, h) do { _Pragma("unroll") for (int n = 0; n < 2; ++n) _Pragma("unroll") for (int k = 0; k < 2; ++k) dst[n][k] = *(const LAS bf16x8*)(lds + PG8_SB(b, h) + boff + n * 2048 + k * 1024); } while (0)
#define PG8_MMA(ai, bj, At, Bt) do { if (KL_PRIO) __builtin_amdgcn_s_setprio(KL_PRIO); _Pragma("unroll") for (int m = 0; m < 4; ++m) _Pragma("unroll") for (int n = 0; n < 2; ++n) _Pragma("unroll") for (int k = 0; k < 2; ++k) { \
        if (PROBE == 1) asm volatile("" :: "v"(Bt[n][k]), "v"(At[m][k])); else acc[ai][bj][m][n] = __builtin_amdgcn_mfma_f32_16x16x32_bf16(Bt[n][k], At[m][k], acc[ai][bj][m][n], 0, 0, 0); } if (KL_PRIO) __builtin_amdgcn_s_setprio(0); } while (0)
#define PG8_MMAZ(ai, bj, At, Bt) do { if (KL_PRIO) __builtin_amdgcn_s_setprio(KL_PRIO); _Pragma("unroll") for (int m = 0; m < 4; ++m) _Pragma("unroll") for (int n = 0; n < 2; ++n) { \
        acc[ai][bj][m][n] = __builtin_amdgcn_mfma_f32_16x16x32_bf16(Bt[n][0], At[m][0], (f32x4){0.f, 0.f, 0.f, 0.f}, 0, 0, 0); \
        acc[ai][bj][m][n] = __builtin_amdgcn_mfma_f32_16x16x32_bf16(Bt[n][1], At[m][1], acc[ai][bj][m][n], 0, 0, 0); } if (KL_PRIO) __builtin_amdgcn_s_setprio(0); } while (0)
#define PG8_WAIT_V(n) asm volatile("s_waitcnt vmcnt(" #n ")" ::: "memory")
#define PG8_WAIT_L(n) asm volatile("s_waitcnt lgkmcnt(" #n ")" ::: "memory")
#define PG8_BAR __builtin_amdgcn_s_barrier()
#define PG8_SCHED __builtin_amdgcn_sched_barrier(0)
    Unit cur, nxt; int ui = 0;
    if (!S.next(0, cur)) return;
    f32x4 acc[2][2][4][2];
    bf16x8 At[4][2], B0[2][2], B1[2][2];
    unsigned cA = (unsigned)cur.pm * tstep, cB = (unsigned)cur.pn * tstep, ks = kstep;
    int slot = 0;
    if constexpr (Epi::NEEDS_RS) prep_rstd(E.SS, cur.pm, (LAS float*)(lds + RS_OFF), tid);
#if KL_SP2
    PG8_STAGE(PG8_SB(0, 0), cB, voffB); PG8_STAGE(PG8_SB(0, 1), cB + hstep, voffB); PG8_STAGE(PG8_SA(0, 0), cA, voffA); PG8_STAGE(PG8_SA(0, 1), cA + hstep, voffA);
    if (wr == 1) PG8_BAR;
    PG8_WAIT_V(2); PG8_BAR;
    PG8_STAGE(PG8_SB(1, 0), cB + ks, voffB); PG8_STAGE(PG8_SA(1, 0), cA + ks, voffA); PG8_STAGE(PG8_SB(1, 1), cB + hstep + ks, voffB);
    PG8_WAIT_V(6); PG8_BAR;
#else
    PG8_STAGE(PG8_SB(0, 0), cB, voffB); PG8_STAGE(PG8_SA(0, 0), cA, voffA); PG8_STAGE(PG8_SB(0, 1), cB + hstep, voffB); PG8_STAGE(PG8_SA(0, 1), cA + hstep, voffA);
    if (wr == 1) PG8_BAR;
    PG8_WAIT_V(4); PG8_BAR;
    PG8_STAGE(PG8_SB(1, 0), cB + ks, voffB); PG8_STAGE(PG8_SA(1, 0), cA + ks, voffA); PG8_STAGE(PG8_SB(1, 1), cB + hstep + ks, voffB);
    PG8_WAIT_V(6); PG8_BAR;
#endif
    for (;;) {
        const bool has_next = S.next(ui + 1, nxt);
        const unsigned nks = has_next ? 0u - ks : ks, nrev = (nks != kstep) ? (unsigned)(nt - 1) * kstep : 0u;
        const unsigned nA = has_next ? (unsigned)nxt.pm * tstep + nrev : cA, nB = has_next ? (unsigned)nxt.pn * tstep + nrev : cB;
        for (int t = 0; t < nt; t += 2) {
            const bool last = (t == nt - 2);
            const unsigned a1 = cA + (unsigned)(t + 1) * ks;
            const unsigned a2 = last ? nA : cA + (unsigned)(t + 2) * ks, b2 = last ? nB : cB + (unsigned)(t + 2) * ks;
            const unsigned a3 = a2 + (last ? nks : ks), b3 = b2 + (last ? nks : ks);
#if KL_SP2
            PG8_LDB(B0, 0, 0); PG8_LDB(B1, 0, 1); PG8_SCHED; PG8_LDA(At, 0, 0); PG8_STAGE(PG8_SA(1, 1), a1 + hstep, voffA);
            PG8_WAIT_V(8); PG8_WAIT_L(0); PG8_BAR; if (t == 0) { PG8_MMAZ(0, 0, At, B0); PG8_MMAZ(0, 1, At, B1); } else { PG8_MMA(0, 0, At, B0); PG8_MMA(0, 1, At, B1); } PG8_BAR; PG8_SCHED;
            PG8_LDA(At, 0, 1); PG8_STAGE(PG8_SB(0, 0), b2, voffB); PG8_STAGE(PG8_SB(0, 1), b2 + hstep, voffB); PG8_STAGE(PG8_SA(0, 0), a2, voffA);
            PG8_WAIT_V(8); PG8_WAIT_L(0); PG8_BAR; if (t == 0) { PG8_MMAZ(1, 0, At, B0); PG8_MMAZ(1, 1, At, B1); } else { PG8_MMA(1, 0, At, B0); PG8_MMA(1, 1, At, B1); } PG8_BAR; PG8_SCHED;
            PG8_LDB(B0, 1, 0); PG8_LDB(B1, 1, 1); PG8_SCHED; PG8_LDA(At, 1, 0); PG8_STAGE(PG8_SA(0, 1), a2 + hstep, voffA);
            PG8_WAIT_V(8); PG8_WAIT_L(0); PG8_BAR; PG8_MMA(0, 0, At, B0); PG8_MMA(0, 1, At, B1); PG8_BAR; PG8_SCHED;
            PG8_LDA(At, 1, 1); PG8_STAGE(PG8_SB(1, 0), b3, voffB); PG8_STAGE(PG8_SB(1, 1), b3 + hstep, voffB); PG8_STAGE(PG8_SA(1, 0), a3, voffA);
            PG8_WAIT_V(8); PG8_WAIT_L(0); PG8_BAR; PG8_MMA(1, 0, At, B0); PG8_MMA(1, 1, At, B1); PG8_BAR; PG8_SCHED;
#else
            PG8_LDB(B0, 0, 0); PG8_SCHED; PG8_LDA(At, 0, 0); PG8_STAGE(PG8_SA(1, 1), a1 + hstep, voffA);
            PG8_WAIT_L(8); PG8_BAR; PG8_WAIT_L(0); PG8_MMA(0, 0, At, B0); PG8_BAR; PG8_SCHED;
            PG8_LDB(B1, 0, 1); PG8_STAGE(PG8_SB(0, 0), b2, voffB);
            PG8_BAR; PG8_WAIT_L(0); PG8_MMA(0, 1, At, B1); PG8_BAR;
            PG8_LDA(At, 0, 1); PG8_STAGE(PG8_SA(0, 0), a2, voffA);
            PG8_BAR; PG8_WAIT_L(0); PG8_MMA(1, 0, At, B0); PG8_BAR; PG8_SCHED;
            PG8_STAGE(PG8_SB(0, 1), b2 + hstep, voffB);
            PG8_WAIT_V(6); PG8_BAR; PG8_MMA(1, 1, At, B1); PG8_BAR;
            PG8_LDB(B0, 1, 0); PG8_SCHED; PG8_LDA(At, 1, 0); PG8_STAGE(PG8_SA(0, 1), a2 + hstep, voffA);
            PG8_WAIT_L(8); PG8_BAR; PG8_WAIT_L(0); PG8_MMA(0, 0, At, B0); PG8_BAR; PG8_SCHED;
            PG8_LDB(B1, 1, 1); PG8_STAGE(PG8_SB(1, 0), b3, voffB);
            PG8_BAR; PG8_WAIT_L(0); PG8_MMA(0, 1, At, B1); PG8_BAR;
            PG8_LDA(At, 1, 1); PG8_STAGE(PG8_SA(1, 0), a3, voffA);
            PG8_BAR; PG8_WAIT_L(0); PG8_MMA(1, 0, At, B0); PG8_BAR; PG8_SCHED;
            PG8_STAGE(PG8_SB(1, 1), b3 + hstep, voffB);
            PG8_WAIT_V(6); PG8_BAR; PG8_MMA(1, 1, At, B1); PG8_BAR;
#endif
        }
        if (KL_ALIGN && wr == 0) PG8_BAR;
        E(acc, cur, wr, wc, fr, fq, (const LAS float*)(lds + RS_OFF) + slot * 256);
        if (!has_next) break;
        if constexpr (Epi::NEEDS_RS) { if (nxt.pm != cur.pm) { slot ^= 1; prep_rstd(E.SS, nxt.pm, (LAS float*)(lds + RS_OFF) + slot * 256, tid); } }
        cur = nxt; cA = nA; cB = nB; ks = nks; ++ui;
        if (KL_ALIGN && wr == 1) PG8_BAR;
    }
    PG8_WAIT_V(0);
    if (!KL_ALIGN && wr == 0) PG8_BAR;
    PG8_BAR;
#undef PG8_SA
#undef PG8_SB
#undef PG8_STAGE
#undef PG8_LDA
#undef PG8_LDB
#undef PG8_MMA
#undef PG8_MMAZ
#undef PG8_WAIT_V
#undef PG8_WAIT_L
#undef PG8_BAR
#undef PG8_SCHED
}
}

struct Args { const float* in[21]; float* out; unsigned char* ws; };
enum { I_X = 0, I_ENORM, I_EWIN, I_LNG, I_LNB, I_SWS, I_SBS, I_PW, I_PB, I_PS, I_EWOUT, I_ONORM, I_OWIN, I_CW, I_CB, I_OWOUT, I_FNORM, I_WG, I_WU, I_WD, I_FINAL };

__device__ __forceinline__ void tr_item(const float* W, int ldw, int k0, int c0, const float* ks, bf16* WT, int K, int drow0, LAS float* scr, int lane) {
    f32x4 v[8]; float sc[8];
    const int kq = lane >> 3, n4 = (lane & 7) * 4;
#pragma unroll
    for (int i = 0; i < 8; ++i) { const int kk = 8 * i + kq; v[i] = __builtin_nontemporal_load((const f32x4*)(W + (size_t)(k0 + kk) * ldw + c0 + n4)); sc[i] = ks ? ks[k0 + kk] : 1.0f; }
#pragma unroll
    for (int i = 0; i < 8; ++i) { const int kk = 8 * i + kq; LAS float* d = scr + kk * 33 + n4; d[0] = v[i].x * sc[i]; d[1] = v[i].y * sc[i]; d[2] = v[i].z * sc[i]; d[3] = v[i].w * sc[i]; }
    asm volatile("s_waitcnt lgkmcnt(0)" ::: "memory");
    const int c = lane & 7;
#pragma unroll
    for (int j = 0; j < 4; ++j) { const int n = (lane >> 3) + 8 * j; const LAS float* s = scr + (8 * c) * 33 + n;
        u32x4 o; o.x = cvt_pk_bf16(s[0 * 33], s[1 * 33]); o.y = cvt_pk_bf16(s[2 * 33], s[3 * 33]); o.z = cvt_pk_bf16(s[4 * 33], s[5 * 33]); o.w = cvt_pk_bf16(s[6 * 33], s[7 * 33]);
        *(u32x4*)(WT + (size_t)(drow0 + n) * K + k0 + 8 * c) = o; }
    asm volatile("s_waitcnt lgkmcnt(0)" ::: "memory");
}

__device__ __forceinline__ void prologue(const Args& a, LAS unsigned char* lds, int wave, int lane) {
    LAS float* scr = (LAS float*)(lds + wave * 16384);
    const int gw = blockIdx.x * 8 + wave, NGW = gridDim.x * 8;
    unsigned char* ws = a.ws;
    constexpr int KB = D / 64;
    constexpr int I1 = KB * (N_IN0 / 32), I2 = KB * (D / 32), I3 = KB * (N_GU / 32), I4 = (FF / 64) * (D / 32), I5 = KB * (N_IN1 / 32), I6 = I2, I7 = I3, I8 = I4, I9 = 4 * 2 * 4, I10 = 128;
    constexpr int NITEMS = I1 + I2 + I3 + I4 + I5 + I6 + I7 + I8 + I9 + I10;
    for (int it = gw; it < NITEMS; it += NGW) {
        int r = it;
        if (r < I1) { const int nb = r % (N_IN0 / 32), kb = r / (N_IN0 / 32); tr_item(a.in[I_EWIN], N_IN0, kb * 64, nb * 32, a.in[I_ENORM], (bf16*)(ws + WS_W1), D, nb * 32, scr, lane); continue; } r -= I1;
        if (r < I2) { const int nb = r % (D / 32), kb = r / (D / 32); tr_item(a.in[I_EWOUT], D, kb * 64, nb * 32, nullptr, (bf16*)(ws + WS_W2), D, nb * 32, scr, lane); continue; } r -= I2;
        if (r < I3 + I4) {
            if (r < I3) { const int nb = r % (N_GU / 32), kb = r / (N_GU / 32), np = nb * 32, pn = np >> 8, bj = (np >> 7) & 1, j0 = np & 127;
                tr_item(bj ? a.in[I_WU] : a.in[I_WG], FF, kb * 64, pn * 128 + j0, a.in[I_FNORM], (bf16*)(ws + WS_W3), D, np, scr, lane); continue; }
            r -= I3; { const int nb = r % (D / 32), kb = r / (D / 32); tr_item(a.in[I_WD], D, kb * 64, nb * 32, nullptr, (bf16*)(ws + WS_W4), FF, nb * 32, scr, lane); continue; }
        } r -= I3 + I4;
        if (r < I5) { const int nb = r % (N_IN1 / 32), kb = r / (N_IN1 / 32), np = nb * 32, pn = np >> 8;
            const int c0 = pn < 8 ? ((((np >> 7) & 1) ? 2048 : 1024) + pn * 128 + (np & 127)) : ((pn - 8) * 256 + (np & 255));
            tr_item(a.in[I_OWIN], N_IN1, kb * 64, c0, a.in[I_ONORM], (bf16*)(ws + WS_W5), D, np, scr, lane); continue; } r -= I5;
        if (r < I6) { const int nb = r % (D / 32), kb = r / (D / 32); tr_item(a.in[I_OWOUT], D, kb * 64, nb * 32, nullptr, (bf16*)(ws + WS_W6), D, nb * 32, scr, lane); continue; } r -= I6;
        if (r < I7 + I8) {
            if (r < I7) { const int nb = r % (N_GU / 32), kb = r / (N_GU / 32), np = nb * 32, pn = np >> 8, bj = (np >> 7) & 1, j0 = np & 127;
                tr_item((bj ? a.in[I_WU] : a.in[I_WG]) + (size_t)D * FF, FF, kb * 64, pn * 128 + j0, a.in[I_FNORM] + D, (bf16*)(ws + WS_W7), D, np, scr, lane); continue; }
            r -= I7; { const int nb = r % (D / 32), kb = r / (D / 32); tr_item(a.in[I_WD] + (size_t)FF * D, D, kb * 64, nb * 32, nullptr, (bf16*)(ws + WS_W8), FF, nb * 32, scr, lane); continue; }
        } r -= I7 + I8;
        if (r < I9) { const int g = r >> 3, kb = (r >> 2) & 1, nb = r & 3;
            tr_item(a.in[I_PW] + (size_t)g * 128 * 128, 128, kb * 64, nb * 32, nullptr, (bf16*)(ws + WS_PWT) + (size_t)g * 128 * 128, 128, nb * 32, scr, lane); continue; } r -= I9;
        {
            const int idx = r * 512 + lane * 8, i = (idx >> 7) & 127, j = idx & 127;
            const f32x4 v0 = *(const f32x4*)(a.in[I_SWS] + idx), v1 = *(const f32x4*)(a.in[I_SWS] + idx + 4);
            u32x4 o; o.x = cvt_pk_bf16(v0[0], v0[1]); o.y = cvt_pk_bf16(v0[2], v0[3]); o.z = cvt_pk_bf16(v1[0], v1[1]); o.w = cvt_pk_bf16(v1[2], v1[3]);
            if ((j >> 6) > (i >> 6)) o = (u32x4){0u, 0u, 0u, 0u};
            *(u32x4*)((bf16*)(ws + WS_WSM) + idx) = o;
        }
    }
    bf16* XB = (bf16*)(ws + WS_XBA); float* SS0 = (float*)(ws + WS_SS);
    for (int m0 = gw * 4; m0 < M; m0 += NGW * 4) {
        f32x4 v[4][4];
#pragma unroll
        for (int r = 0; r < 4; ++r)
#pragma unroll
            for (int j = 0; j < 4; ++j) v[r][j] = __builtin_nontemporal_load((const f32x4*)(a.in[I_X] + (size_t)(m0 + r) * D) + lane + 64 * j);
#pragma unroll
        for (int r = 0; r < 4; ++r) { float s = 0.f;
#pragma unroll
            for (int j = 0; j < 4; ++j) s += (v[r][j].x * v[r][j].x + v[r][j].y * v[r][j].y) + (v[r][j].z * v[r][j].z + v[r][j].w * v[r][j].w);
            s = wave_sum(s);
            u32x2* o8 = (u32x2*)(XB + (size_t)(m0 + r) * D) + lane;
#pragma unroll
            for (int j = 0; j < 4; ++j) { u32x2 w; w.x = cvt_pk_bf16(v[r][j].x, v[r][j].y); w.y = cvt_pk_bf16(v[r][j].z, v[r][j].w); o8[64 * j] = w; }
            if (lane < 16) SS0[(size_t)(m0 + r) * 16 + lane] = lane == 0 ? s : 0.f; }
    }
}

constexpr int TS = 272;
constexpr int MX_VT0 = 0, MX_VT1 = 128 * TS, MX_PL = 2 * 128 * TS, MX_DL = MX_PL + 144 * TS, MX_ST = MX_DL + 128 * TS;
static_assert(MX_ST + 1024 <= MISC_OFF, "mixer LDS map");
__device__ __forceinline__ void unpack8(const u32x4 v, float (&f)[8]) { f[0] = bf_lo(v.x); f[1] = bf_hi(v.x); f[2] = bf_lo(v.y); f[3] = bf_hi(v.y); f[4] = bf_lo(v.z); f[5] = bf_hi(v.z); f[6] = bf_lo(v.w); f[7] = bf_hi(v.w); }
__device__ __forceinline__ void mixer_phase(const Args& a, LAS unsigned char* lds, int tid, int wave, int lane) {
    unsigned char* ws = a.ws;
    const bf16* H0 = (const bf16*)(ws + WS_H0); bf16* MIX = (bf16*)(ws + WS_MIX);
    const bf16* WsM = (const bf16*)(ws + WS_WSM); const bf16* PwT = (const bf16*)(ws + WS_PWT);
    LAS float* st_mu = (LAS float*)(lds + MX_ST); LAS float* st_rs = st_mu + 128;
    LAS unsigned char* Pl = lds + MX_PL; LAS unsigned char* Dl = lds + MX_DL;
    const int fr = lane & 15, fq = lane >> 4;
    for (int blk = blockIdx.x; blk < M / 128; blk += gridDim.x) {
        const int R0 = blk * 128;
        const int tseq0 = (blk & (SEQ / 128 - 1)) * 128;
        u32x4 zr[16];
#pragma unroll
        for (int i = 0; i < 16; ++i) zr[i] = *(const u32x4*)(H0 + (size_t)(R0 + 16 * wave + i) * N_IN0 + 512 + lane * 8);
        u32x4 zq[2][2];
#pragma unroll
        for (int it = 0; it < 2; ++it) { const int c = (wave + 8 * it) * 8;
            zq[it][0] = *(const u32x4*)(H0 + (size_t)(R0 + 2 * lane) * N_IN0 + 512 + c); zq[it][1] = *(const u32x4*)(H0 + (size_t)(R0 + 2 * lane + 1) * N_IN0 + 512 + c); }
#pragma unroll
        for (int i = 0; i < 16; ++i) { float z[8]; unpack8(zr[i], z);
            float s = 0.f, q = 0.f;
#pragma unroll
            for (int e = 0; e < 8; ++e) { s += z[e]; q += z[e] * z[e]; }
#pragma unroll
            for (int o = 1; o < 64; o <<= 1) { s += __shfl_xor(s, o); q += __shfl_xor(q, o); }
            const float mean = s * (1.0f / 512.0f), var = fmaxf(q * (1.0f / 512.0f) - mean * mean, 0.f);
            if (lane == 0) { st_mu[16 * wave + i] = mean; st_rs[16 * wave + i] = __builtin_amdgcn_rsqf(var + EPS); } }
        __syncthreads();
        u32x4 pq[5];
#pragma unroll
        for (int h = 0; h < 4; ++h) {
            LAS unsigned char* buf = lds + ((h & 1) ? MX_VT1 : MX_VT0);
            {   const int j = 2 * lane; const float m0 = st_mu[j], s0 = st_rs[j], m1 = st_mu[j + 1], s1 = st_rs[j + 1];
#pragma unroll
                for (int it = 0; it < 2; ++it) { const int doct = wave + 8 * it, c = h * 128 + doct * 8;
                    const f32x4 g0 = *(const f32x4*)(a.in[I_LNG] + c), g1 = *(const f32x4*)(a.in[I_LNG] + c + 4), b0 = *(const f32x4*)(a.in[I_LNB] + c), b1 = *(const f32x4*)(a.in[I_LNB] + c + 4);
                    float za[8], zb[8]; unpack8(zq[it][0], za); unpack8(zq[it][1], zb);
                    const float gg[8] = {g0[0], g0[1], g0[2], g0[3], g1[0], g1[1], g1[2], g1[3]}, bb[8] = {b0[0], b0[1], b0[2], b0[3], b1[0], b1[1], b1[2], b1[3]};
#pragma unroll
                    for (int e = 0; e < 8; ++e) { const float va = (za[e] - m0) * s0 * gg[e] + bb[e], vb = (zb[e] - m1) * s1 * gg[e] + bb[e];
                        *(LAS unsigned*)(buf + (doct * 8 + e) * TS + j * 2) = cvt_pk_bf16(va, vb); } } }
            const int i0 = 16 * wave, nks = wave < 4 ? 2 : 4;
            bf16x8 wf[4];
#pragma unroll
            for (int ks = 0; ks < 4; ++ks) wf[ks] = *(const bf16x8*)(WsM + (size_t)(h * 128 + i0 + fr) * 128 + ks * 32 + fq * 8);
            const size_t rrow = (size_t)(R0 + i0 + fr);
            u32x2 ur[8];
#pragma unroll
            for (int dt = 0; dt < 8; ++dt) ur[dt] = *(const u32x2*)(H0 + rrow * N_IN0 + h * 128 + dt * 16 + 4 * fq);
            const float bsv = a.in[I_SBS][(i0 + fr) * 4 + h];
            if (h < 3) {
#pragma unroll
                for (int it = 0; it < 2; ++it) { const int c = (h + 1) * 128 + (wave + 8 * it) * 8;
                    zq[it][0] = *(const u32x4*)(H0 + (size_t)(R0 + 2 * lane) * N_IN0 + 512 + c); zq[it][1] = *(const u32x4*)(H0 + (size_t)(R0 + 2 * lane + 1) * N_IN0 + 512 + c); }
            } else {
#pragma unroll
                for (int it = 0; it < 5; ++it) { const int task = tid + 512 * it, rr = task >> 4, oc = task & 15, t = rr - 16; pq[it] = (u32x4){0u, 0u, 0u, 0u};
                    if (task < 144 * 16 && tseq0 + t >= 0) pq[it] = *(const u32x4*)(H0 + (size_t)(R0 + t) * N_IN0 + 1024 + oc * 8); }
            }
            __syncthreads();
            f32x4 acc[8];
#pragma unroll
            for (int dt = 0; dt < 8; ++dt) acc[dt] = (f32x4){0.f, 0.f, 0.f, 0.f};
#pragma unroll
            for (int ks = 0; ks < 4; ++ks) if (ks < nks) {
#pragma unroll
                for (int dt = 0; dt < 8; ++dt) { const bf16x8 vf = *(const LAS bf16x8*)(buf + (dt * 16 + fr) * TS + (ks * 32 + fq * 8) * 2);
                    acc[dt] = __builtin_amdgcn_mfma_f32_16x16x32_bf16(vf, wf[ks], acc[dt], 0, 0, 0); } }
#pragma unroll
            for (int dt = 0; dt < 8; ++dt) { const int col = h * 128 + dt * 16 + 4 * fq;
                u32x2 w; w.x = cvt_pk_bf16(bf_lo(ur[dt].x) * (acc[dt][0] + bsv), bf_hi(ur[dt].x) * (acc[dt][1] + bsv)); w.y = cvt_pk_bf16(bf_lo(ur[dt].y) * (acc[dt][2] + bsv), bf_hi(ur[dt].y) * (acc[dt][3] + bsv));
                *(u32x2*)(MIX + rrow * D + col) = w; }
        }
#pragma unroll
        for (int g = 0; g < 4; ++g) {
            const int win = 2 << g;
#pragma unroll
            for (int it = 0; it < 5; ++it) { const int task = tid + 512 * it, rr = task >> 4, oc = task & 15; if (task < 144 * 16) *(LAS u32x4*)(Pl + rr * TS + oc * 16) = pq[it]; }
            bf16x8 wf[4];
#pragma unroll
            for (int ks = 0; ks < 4; ++ks) wf[ks] = *(const bf16x8*)(PwT + (size_t)(g * 128 + wave * 16 + fr) * 128 + ks * 32 + fq * 8);
            const int n = g * 128 + wave * 16 + 4 * fq;
            const f32x4 pb = *(const f32x4*)(a.in[I_PB] + n), ps = *(const f32x4*)(a.in[I_PS] + n);
            if (g < 3) {
#pragma unroll
                for (int it = 0; it < 5; ++it) { const int task = tid + 512 * it, rr = task >> 4, oc = task & 15, t = rr - 16; pq[it] = (u32x4){0u, 0u, 0u, 0u};
                    if (task < 144 * 16 && tseq0 + t >= 0) pq[it] = *(const u32x4*)(H0 + (size_t)(R0 + t) * N_IN0 + 1024 + (g + 1) * 128 + oc * 8); }
            }
            __syncthreads();
#pragma unroll
            for (int it = 0; it < 4; ++it) { const int task = tid + 512 * it, t = task >> 4, oc = task & 15;
                float s[8] = {0.f, 0.f, 0.f, 0.f, 0.f, 0.f, 0.f, 0.f}; u32x4 cur = (u32x4){0u, 0u, 0u, 0u};
#pragma unroll
                for (int k = 0; k < 16; ++k) if (k < win) { const u32x4 v = *(const LAS u32x4*)(Pl + (16 + t - k) * TS + oc * 16); if (k == 0) cur = v;
                    s[0] += bf_lo(v.x); s[1] += bf_hi(v.x); s[2] += bf_lo(v.y); s[3] += bf_hi(v.y); s[4] += bf_lo(v.z); s[5] += bf_hi(v.z); s[6] += bf_lo(v.w); s[7] += bf_hi(v.w); }
                const int cnt = (tseq0 + t + 1) < win ? (tseq0 + t + 1) : win; const float ic = 1.0f / (float)cnt;
                u32x4 o; o.x = cvt_pk_bf16(s[0] * ic - bf_lo(cur.x), s[1] * ic - bf_hi(cur.x)); o.y = cvt_pk_bf16(s[2] * ic - bf_lo(cur.y), s[3] * ic - bf_hi(cur.y));
                o.z = cvt_pk_bf16(s[4] * ic - bf_lo(cur.z), s[5] * ic - bf_hi(cur.z)); o.w = cvt_pk_bf16(s[6] * ic - bf_lo(cur.w), s[7] * ic - bf_hi(cur.w));
                *(LAS u32x4*)(Dl + t * TS + oc * 16) = o; }
            __syncthreads();
#pragma unroll 2
            for (int tt = 0; tt < 8; ++tt) { f32x4 acc = (f32x4){0.f, 0.f, 0.f, 0.f};
#pragma unroll
                for (int ks = 0; ks < 4; ++ks) { const bf16x8 df = *(const LAS bf16x8*)(Dl + (tt * 16 + fr) * TS + (ks * 32 + fq * 8) * 2);
                    acc = __builtin_amdgcn_mfma_f32_16x16x32_bf16(wf[ks], df, acc, 0, 0, 0); }
                u32x2 w; w.x = cvt_pk_bf16((acc[0] + pb[0]) * ps[0], (acc[1] + pb[1]) * ps[1]); w.y = cvt_pk_bf16((acc[2] + pb[2]) * ps[2], (acc[3] + pb[3]) * ps[3]);
                *(u32x2*)(MIX + (size_t)(R0 + tt * 16 + fr) * D + 512 + n) = w; }
        }
        __syncthreads();
    }
}

__device__ __forceinline__ void conv_phase(const Args& a, int tid) {
    unsigned char* ws = a.ws;
    const bf16* Q1 = (const bf16*)(ws + WS_Q1); const bf16* BG = (const bf16*)(ws + WS_BG); bf16* CV = (bf16*)(ws + WS_CV);
    const int oc = tid & 127, rsub = tid >> 7, c = oc * 8;
    float w0[8], w1[8], w2[8], cb[8];
    { const float* cw = a.in[I_CW]; const float* cbp = a.in[I_CB];
#pragma unroll
      for (int e = 0; e < 8; ++e) { w0[e] = cw[c + e]; w1[e] = cw[D + c + e]; w2[e] = cw[2 * D + c + e]; cb[e] = cbp[c + e]; } }
    for (int ch = blockIdx.x; ch < M / 64; ch += gridDim.x) {
        const int r0 = ch * 64 + rsub * 16;
        u32x4 qv[18], bv[16];
        const bool first = (r0 & (SEQ - 1)) == 0;
        qv[0] = (u32x4){0u, 0u, 0u, 0u}; qv[1] = qv[0];
        if (!first) { qv[0] = *(const u32x4*)(Q1 + (size_t)(r0 - 2) * D + c); qv[1] = *(const u32x4*)(Q1 + (size_t)(r0 - 1) * D + c); }
#pragma unroll
        for (int i = 0; i < 16; ++i) { const size_t off = (size_t)(r0 + i) * D + c; qv[i + 2] = *(const u32x4*)(Q1 + off); bv[i] = *(const u32x4*)(BG + off); }
        float qm2[8], qm1[8]; unpack8(qv[0], qm2); unpack8(qv[1], qm1);
#pragma unroll
        for (int i = 0; i < 16; ++i) { const size_t off = (size_t)(r0 + i) * D + c;
            float q[8], b[8]; unpack8(qv[i + 2], q); unpack8(bv[i], b);
            float y[8];
#pragma unroll
            for (int e = 0; e < 8; ++e) { y[e] = b[e] * (cb[e] + w0[e] * qm2[e] + w1[e] * qm1[e] + w2[e] * q[e]); qm2[e] = qm1[e]; qm1[e] = q[e]; }
            u32x4 o; o.x = cvt_pk_bf16(y[0], y[1]); o.y = cvt_pk_bf16(y[2], y[3]); o.z = cvt_pk_bf16(y[4], y[5]); o.w = cvt_pk_bf16(y[6], y[7]);
            *(u32x4*)(CV + off) = o; }
    }
}

__device__ __forceinline__ void final_phase(const Args& a, float* dst, int wave, int lane) {
    const float* SS = (const float*)(a.ws + WS_SS + 4 * SS_BYTES); const bf16* X4 = (const bf16*)(a.ws + WS_XBA);
    const int gw = blockIdx.x * 8 + wave, NGW = gridDim.x * 8;
    f32x4 g[2][2];
#pragma unroll
    for (int j = 0; j < 2; ++j) { g[j][0] = *(const f32x4*)(a.in[I_FINAL] + j * 512 + lane * 8); g[j][1] = *(const f32x4*)(a.in[I_FINAL] + j * 512 + lane * 8 + 4); }
    for (int m0 = gw * 4; m0 < M; m0 += NGW * 4) {
        f32x4 p[4]; u32x4 v[4][2];
#pragma unroll
        for (int r = 0; r < 4; ++r) { p[r] = *(const f32x4*)(SS + (size_t)(m0 + r) * 16 + 4 * (lane & 3));
#pragma unroll
            for (int j = 0; j < 2; ++j) v[r][j] = *(const u32x4*)(X4 + (size_t)(m0 + r) * D + j * 512 + lane * 8); }
#pragma unroll
        for (int r = 0; r < 4; ++r) { float s = (p[r].x + p[r].y) + (p[r].z + p[r].w); s += __shfl_xor(s, 1); s += __shfl_xor(s, 2);
            const float rstd = __builtin_amdgcn_rsqf(s * (1.0f / 1024.0f) + EPS);
#pragma unroll
            for (int j = 0; j < 2; ++j) { float* o = dst + (size_t)(m0 + r) * D + j * 512 + lane * 8;
                *(f32x4*)o = (f32x4){bf_lo(v[r][j].x), bf_hi(v[r][j].x), bf_lo(v[r][j].y), bf_hi(v[r][j].y)} * rstd * g[j][0];
                *(f32x4*)(o + 4) = (f32x4){bf_lo(v[r][j].z), bf_hi(v[r][j].z), bf_lo(v[r][j].w), bf_hi(v[r][j].w)} * rstd * g[j][1]; } }
    }
}

template <int layer>
__device__ __forceinline__ void layer_tail(const Args& a, LAS unsigned char* lds, const XcdBarrier& xb, int tid, int G, int c) {
    unsigned char* ws = a.ws;
    float* SS = (float*)(ws + WS_SS);
    constexpr size_t SSF = SS_BYTES / 4;
    if (layer == 1) {
        {
            pg8::Gemm g{(const bf16*)(ws + WS_XBA), (const bf16*)(ws + WS_W5), M, 2 * D, D}; pg8::StaticOrder S; S.init(M, 2 * D, G, c);
            pg8::EpiQ E{(bf16*)(ws + WS_Q1), SS + 2 * SSF};
            pg8::gemm_phase(lds, g, S, E);
        }
        xcd_barrier(xb);
        {
            pg8::Gemm g{(const bf16*)(ws + WS_XBA), (const bf16*)(ws + WS_W5) + (size_t)2 * D * D, M, D, D}; pg8::StaticOrder S; S.init(M, D, G, c); S.rev = 1;
            pg8::EpiConvGate E{(const bf16*)(ws + WS_Q1), (bf16*)(ws + WS_CV), SS + 2 * SSF, a.in[I_CW], a.in[I_CB]};
            pg8::gemm_phase(lds, g, S, E);
        }
        xcd_barrier(xb);
    }
    {
        pg8::Gemm g{(const bf16*)(ws + (layer ? WS_CV : WS_MIX)), (const bf16*)(ws + (layer ? WS_W6 : WS_W2)), M, D, D}; pg8::StaticOrder S; S.init(M, D, G, c);
        pg8::EpiRes E{(const bf16*)(ws + WS_XBA), (bf16*)(ws + WS_XBB), SS + (layer ? 3 : 1) * SSF};
        if (DUP & 4) pg8::gemm_phase(lds, g, S, E);
        pg8::gemm_phase(lds, g, S, E);
    }
    xcd_barrier(xb);
    {
        pg8::Gemm g{(const bf16*)(ws + WS_XBB), (const bf16*)(ws + (layer ? WS_W7 : WS_W3)), M, N_GU, D}; pg8::StaticOrder S; S.init(M, N_GU, G, c); S.rev = layer;
        pg8::EpiSwiglu E{(bf16*)(ws + WS_ACT), SS + (layer ? 3 : 1) * SSF};
        pg8::gemm_phase(lds, g, S, E);
        if ((DUP & 2) && layer == 0) pg8::gemm_phase(lds, g, S, E);
        if ((DUP & 16) && layer == 0) { pg8::EpiNull E0{(float*)(ws + WS_END)}; pg8::StaticOrder S2 = S; S2.fixed = (DUP >> 12) & 1; pg8::gemm_phase<pg8::EpiNull, ((DUP >> 8) & 15)>(lds, g, S2, E0); }
    }
    xcd_barrier(xb);
    {
        pg8::Gemm g{(const bf16*)(ws + WS_ACT), (const bf16*)(ws + (layer ? WS_W8 : WS_W4)), M, D, FF}; pg8::StaticOrder S; S.init(M, D, G, c); S.rev = 1 - layer;
        pg8::EpiRes E{(const bf16*)(ws + WS_XBB), (bf16*)(ws + WS_XBA), SS + (layer ? 4 : 2) * SSF};
        if ((DUP & 8) && layer == 0) pg8::gemm_phase(lds, g, S, E);
        pg8::gemm_phase(lds, g, S, E);
    }
    xcd_barrier(xb);
}

__global__ void __launch_bounds__(512, 2) fwd_megakernel(Args a) {
    extern __shared__ __attribute__((aligned(16))) unsigned char lds_raw[];
    LAS unsigned char* lds = (LAS unsigned char*)lds_raw;
    cg::grid_group grid = cg::this_grid();
    const int tid = threadIdx.x, lane = tid & 63, wave = __builtin_amdgcn_readfirstlane(tid >> 6);
    unsigned char* ws = a.ws;
    const int G = gridDim.x, c = blockIdx.x;
    float* SS = (float*)(ws + WS_SS);
    constexpr size_t SSF = SS_BYTES / 4;

    if (tid < 32) ((volatile LAS unsigned*)(lds + MISC_OFF))[tid] = 0u;
    unsigned* barw = (unsigned*)(ws + WS_CTL);
    __syncthreads();
    const XcdBarrier xb = xcd_barrier_post(barw, (volatile LAS unsigned*)(lds + MISC_OFF) + 8);
    { int t_ = threadIdx.x; asm volatile("" : "+v"(t_)); prologue(a, lds, __builtin_amdgcn_readfirstlane(t_ >> 6), t_ & 63); }
    if (DUP & 32) { __syncthreads(); prologue(a, lds, wave, lane); }
    if (a.ws == nullptr) grid.sync();
    xcd_barrier(xb);
    {
        pg8::Gemm g{(const bf16*)(ws + WS_XBA), (const bf16*)(ws + WS_W1), M, N_IN0, D}; pg8::StaticOrder S; S.init(M, N_IN0, G, c);
        pg8::EpiNormAct E{(bf16*)(ws + WS_H0), N_IN0, SS, 4};
        pg8::gemm_phase(lds, g, S, E);
        if (DUP & 128) pg8::gemm_phase(lds, g, S, E);
    }
    xcd_barrier(xb);
    { int t_ = threadIdx.x; asm volatile("" : "+v"(t_)); mixer_phase(a, lds, t_, __builtin_amdgcn_readfirstlane(t_ >> 6), t_ & 63); }
    if (DUP & 64) { __syncthreads(); mixer_phase(a, lds, tid, wave, lane); }
    xcd_barrier(xb);
    layer_tail<0>(a, lds, xb, tid, G, c);
    layer_tail<1>(a, lds, xb, tid, G, c);
    if (DUP & 1) final_phase(a, (float*)(ws + WS_END), wave, lane);
    { int t_ = threadIdx.x; asm volatile("" : "+v"(t_)); final_phase(a, a.out, __builtin_amdgcn_readfirstlane(t_ >> 6), t_ & 63); }
}

extern "C" void kernel_launch(void* const* d_in, const int* in_sizes, int n_in, void* d_out, int out_size, void* d_ws, size_t ws_size, hipStream_t stream) {
    static int grid = 0;
    if (grid == 0) {
        if (n_in != 21 || in_sizes[0] != M * D || out_size != M * D || ws_size < WS_END) { fprintf(stderr, "kernel_launch: unexpected shapes (n_in %d, ws %zu)\n", n_in, ws_size); grid = -1; return; }
        int dev = 0, cus = 0, per_cu = 0;
        hipGetDevice(&dev);
        hipDeviceGetAttribute(&cus, hipDeviceAttributeMultiprocessorCount, dev);
        hipFuncSetAttribute((const void*)fwd_megakernel, hipFuncAttributeMaxDynamicSharedMemorySize, LDS_BYTES);
        hipOccupancyMaxActiveBlocksPerMultiprocessor(&per_cu, (const void*)fwd_megakernel, 512, LDS_BYTES);
        if (per_cu < 1) { fprintf(stderr, "kernel_launch: occupancy query says %d blocks per CU\n", per_cu); per_cu = 1; }
        (void)hipGetLastError();
        grid = cus;
    }
    if (grid < 0) return;
    if (hipMemsetAsync((char*)d_ws + WS_CTL, 0, XCD_BAR_WORDS * sizeof(unsigned), stream) != hipSuccess) { fprintf(stderr, "kernel_launch: memset of the barrier words failed\n"); return; }
    Args a{};
    for (int i = 0; i < 21; ++i) a.in[i] = (const float*)d_in[i];
    a.out = (float*)d_out; a.ws = (unsigned char*)d_ws;
    void* args[] = {&a};
    hipError_t e = hipLaunchCooperativeKernel((const void*)fwd_megakernel, dim3(grid), dim3(512), args, LDS_BYTES, stream);
    if (e != hipSuccess) fprintf(stderr, "cooperative launch failed: %s (grid %d)\n", hipGetErrorString(e), grid);
}
```
